# Optimizing an MI355X kernel written in HIP

```python
import math, functools
import jax, jax.numpy as jnp
from jax import lax
import numpy as np

D_MODEL = 2048
BATCH = 8
SEQ = 4096
DEPTH = 1
DEC_BATCH = 16
DEC_SEQ = 16
PAST_LEN = 4096

CHUNK = 64
BAND_PAST_CHUNKS = 8
BAND_PAST = BAND_PAST_CHUNKS * CHUNK
BAND = BAND_PAST + CHUNK
ATT_HEADS = 16
ATT_HEAD_DIM = 64
ATT_WIDTH = ATT_HEADS * ATT_HEAD_DIM
REL_CLIP = 128
SSM_GROUP = 16
SSM_WIDTH = 1024
SSM_GROUPS = SSM_WIDTH // SSM_GROUP
SSM_STATE = 64
N_MEM = 256
MEM_HEADS = 4
MEM_HEAD_DIM = 256
MEM_WIDTH = MEM_HEADS * MEM_HEAD_DIM
N_BRANCH = 3
D_FF = 5632
EPS = 1e-6
DT_MIN = 1e-3
DT_MAX = 1e-1
IN_WIDTH = SSM_WIDTH + 3 * ATT_WIDTH + MEM_WIDTH + N_BRANCH * D_MODEL
SPLITS = [SSM_WIDTH, SSM_WIDTH + ATT_WIDTH, SSM_WIDTH + 2 * ATT_WIDTH, SSM_WIDTH + 3 * ATT_WIDTH,
          SSM_WIDTH + 3 * ATT_WIDTH + MEM_WIDTH]
NEG_INF = -1e30

kernel_name = "hybrid_streaming_encoder_step"


def rms_norm(x, g):
    xf = x.astype(jnp.float32)
    y = xf * lax.rsqrt(jnp.mean(xf * xf, axis=-1, keepdims=True) + EPS)
    return (y * g.astype(jnp.float32)).astype(x.dtype)


def swiglu(x, wg, wu, wd):
    return (jax.nn.silu(x @ wg) * (x @ wu)) @ wd


def macaron_ffn(h, g_pre, g_post, wg, wu, wd):
    return h + 0.5 * rms_norm(swiglu(rms_norm(h, g_pre), wg, wu, wd), g_post)


def s5_discretize(a_re, a_im, log_dt, b_re, b_im):
    a_re = a_re.astype(jnp.float32)
    a_im = a_im.astype(jnp.float32)
    dt = jnp.exp(log_dt.astype(jnp.float32))[:, None]
    mag = jnp.exp(a_re * dt)
    ab_re = mag * jnp.cos(a_im * dt)
    ab_im = mag * jnp.sin(a_im * dt)
    den = a_re * a_re + a_im * a_im
    n_re = ab_re - 1.0
    n_im = ab_im
    c_re = (n_re * a_re + n_im * a_im) / den
    c_im = (n_im * a_re - n_re * a_im) / den
    b_re = b_re.astype(jnp.float32)
    b_im = b_im.astype(jnp.float32)
    bb_re = c_re[..., None] * b_re - c_im[..., None] * b_im
    bb_im = c_re[..., None] * b_im + c_im[..., None] * b_re
    return ab_re, ab_im, bb_re, bb_im


def _complex_affine_combine(e1, e2):
    a1r, a1i, b1r, b1i = e1
    a2r, a2i, b2r, b2i = e2
    ar = a2r * a1r - a2i * a1i
    ai = a2r * a1i + a2i * a1r
    br = a2r * b1r - a2i * b1i + b2r
    bi = a2r * b1i + a2i * b1r + b2i
    return ar, ai, br, bi


def s5_branch(u, s0_re, s0_im, p):
    n_b, t, _ = u.shape
    uf = u.astype(jnp.float32).reshape(n_b, t, SSM_GROUPS, SSM_GROUP)
    ab_re, ab_im, bb_re, bb_im = s5_discretize(p["ssm_a_re"], p["ssm_a_im"], p["ssm_log_dt"],
                                               p["ssm_b_re"], p["ssm_b_im"])
    bu_re = jnp.einsum("gph,btgh->btgp", bb_re, uf)
    bu_im = jnp.einsum("gph,btgh->btgp", bb_im, uf)
    s0_re = s0_re.astype(jnp.float32)
    s0_im = s0_im.astype(jnp.float32)
    bu_re = bu_re.at[:, 0].add(ab_re * s0_re - ab_im * s0_im)
    bu_im = bu_im.at[:, 0].add(ab_re * s0_im + ab_im * s0_re)
    a_re_t = jnp.broadcast_to(ab_re, (1, t, SSM_GROUPS, SSM_STATE))
    a_im_t = jnp.broadcast_to(ab_im, (1, t, SSM_GROUPS, SSM_STATE))
    _, _, s_re, s_im = lax.associative_scan(_complex_affine_combine, (a_re_t, a_im_t, bu_re, bu_im), axis=1)
    c_re = p["ssm_c_re"].astype(jnp.float32)
    c_im = p["ssm_c_im"].astype(jnp.float32)
    y = (jnp.einsum("ghp,btgp->btgh", c_re, s_re) - jnp.einsum("ghp,btgp->btgh", c_im, s_im)
         + p["ssm_d"].astype(jnp.float32) * uf)
    y = jax.nn.gelu(y.reshape(n_b, t, SSM_WIDTH))
    out = y * jax.nn.sigmoid(y @ p["ssm_w_glu"].astype(jnp.float32) + p["ssm_b_glu"].astype(jnp.float32))
    return out.astype(u.dtype), s_re[:, -1], s_im[:, -1]


def band_attend(q, k, v, q_pos, k_pos, rel_bias):
    s = jnp.einsum("bqhd,bkhd->bhqk", q, k).astype(jnp.float32) * (ATT_HEAD_DIM ** -0.5)
    rel = jnp.clip(q_pos[:, None] - k_pos[None, :], -REL_CLIP, REL_CLIP) + REL_CLIP
    s = s + rel_bias.astype(jnp.float32)[:, rel]
    q_chunk = q_pos // CHUNK
    k_chunk = k_pos // CHUNK
    ok = ((k_pos[None, :] >= 0) & (k_chunk[None, :] <= q_chunk[:, None])
          & (k_chunk[None, :] >= q_chunk[:, None] - BAND_PAST_CHUNKS))
    s = jnp.where(ok, s, NEG_INF)
    prob = jax.nn.softmax(s, axis=-1)
    return jnp.einsum("bhqk,bkhd->bqhd", prob.astype(v.dtype), v)


def band_attention_prompt(q, k, v, rel_bias):
    n_b, t, _, _ = q.shape
    n_chunks = t // CHUNK
    kp = jnp.pad(k, ((0, 0), (BAND_PAST, 0), (0, 0), (0, 0)))
    vp = jnp.pad(v, ((0, 0), (BAND_PAST, 0), (0, 0), (0, 0)))

    def one_chunk(c):
        start = c * CHUNK
        q_c = lax.dynamic_slice_in_dim(q, start, CHUNK, axis=1)
        k_c = lax.dynamic_slice_in_dim(kp, start, BAND, axis=1)
        v_c = lax.dynamic_slice_in_dim(vp, start, BAND, axis=1)
        q_pos = start + jnp.arange(CHUNK)
        k_pos = start - BAND_PAST + jnp.arange(BAND)
        return band_attend(q_c, k_c, v_c, q_pos, k_pos, rel_bias)

    o = lax.map(one_chunk, jnp.arange(n_chunks))
    return jnp.moveaxis(o, 0, 1).reshape(n_b, t, ATT_WIDTH)


def band_attention_sample(q, k, v, rel_bias, k_cache, v_cache):
    n_b, t, _, _ = q.shape
    w = k_cache.shape[1]
    k_all = jnp.concatenate([k_cache.astype(k.dtype), k], axis=1)
    v_all = jnp.concatenate([v_cache.astype(v.dtype), v], axis=1)
    q_pos = PAST_LEN + jnp.arange(t)
    k_pos = PAST_LEN - w + jnp.arange(w + t)
    o = band_attend(q, k_all, v_all, q_pos, k_pos, rel_bias)
    return o.reshape(n_b, t, ATT_WIDTH)


def memory_attend(q, mem_k, mem_v):
    n_b, t, _, _ = q.shape
    s = jnp.einsum("bqhd,bmhd->bhqm", q, mem_k.astype(q.dtype)).astype(jnp.float32) * (MEM_HEAD_DIM ** -0.5)
    prob = jax.nn.softmax(s, axis=-1)
    o = jnp.einsum("bhqm,bmhd->bqhd", prob.astype(q.dtype), mem_v.astype(q.dtype))
    return o.reshape(n_b, t, MEM_WIDTH)


def memory_kv(mem, g, w_k, w_v):
    n_b = mem.shape[0]
    m = rms_norm(mem, g)
    mk = (m @ w_k).reshape(n_b, N_MEM, MEM_HEADS, MEM_HEAD_DIM)
    mv = (m @ w_v).reshape(n_b, N_MEM, MEM_HEADS, MEM_HEAD_DIM)
    return mk, mv


def layer_forward(h, p, attn_fn, s0_re, s0_im, mem_k, mem_v):
    h = macaron_ffn(h, p["ffn1_norm_pre"], p["ffn1_norm_post"], p["ffn1_w_gate"], p["ffn1_w_up"], p["ffn1_w_down"])
    n_b, t, _ = h.shape
    u = rms_norm(h, p["mix_norm_pre"])
    proj = u @ p["w_in"]
    u_s, q, k, v, q_mem, gate_logits = jnp.split(proj, SPLITS, axis=-1)
    q = q.reshape(n_b, t, ATT_HEADS, ATT_HEAD_DIM)
    k = k.reshape(n_b, t, ATT_HEADS, ATT_HEAD_DIM)
    v = v.reshape(n_b, t, ATT_HEADS, ATT_HEAD_DIM)
    q_mem = q_mem.reshape(n_b, t, MEM_HEADS, MEM_HEAD_DIM)
    o_s, s_re, s_im = s5_branch(u_s, s0_re, s0_im, p)
    o_a = attn_fn(q, k, v, p["att_rel_bias"])
    o_m = memory_attend(q_mem, mem_k, mem_v)
    gates = jax.nn.sigmoid(gate_logits.reshape(n_b, t, N_BRANCH, D_MODEL))
    merged = (gates[:, :, 0] * (o_s @ p["w_branch_ssm"])
              + gates[:, :, 1] * (o_a @ p["w_branch_att"])
              + gates[:, :, 2] * (o_m @ p["w_branch_mem"]))
    h = h + rms_norm(merged @ p["w_out"], p["mix_norm_post"])
    h = macaron_ffn(h, p["ffn2_norm_pre"], p["ffn2_norm_post"], p["ffn2_w_gate"], p["ffn2_w_up"], p["ffn2_w_down"])
    return h, k, v, s_re, s_im


def setup_inputs(seed: int = 0) -> dict:
    key = jax.random.key(seed)
    ks = iter(jax.random.split(key, 64))
    f32 = jnp.float32

    def nrm(shape, scale):
        return jax.random.normal(next(ks), shape, f32) * scale

    def gain(shape):
        return 1.0 + nrm(shape, 0.02)

    att_cache = min(BAND_PAST, PAST_LEN)
    inp = {}
    inp["x_prompt"] = nrm((BATCH, SEQ, D_MODEL), 1.0)
    inp["x_sample"] = nrm((DEC_BATCH, DEC_SEQ, D_MODEL), 1.0)
    inp["mem_prompt"] = nrm((BATCH, N_MEM, D_MODEL), 1.0)
    inp["cache_att_k"] = nrm((DEPTH, DEC_BATCH, att_cache, ATT_HEADS, ATT_HEAD_DIM), 1.0)
    inp["cache_att_v"] = nrm((DEPTH, DEC_BATCH, att_cache, ATT_HEADS, ATT_HEAD_DIM), 1.0)
    inp["cache_mem_k"] = nrm((DEPTH, DEC_BATCH, N_MEM, MEM_HEADS, MEM_HEAD_DIM), 1.0)
    inp["cache_mem_v"] = nrm((DEPTH, DEC_BATCH, N_MEM, MEM_HEADS, MEM_HEAD_DIM), 1.0)
    inp["state_ssm_re"] = nrm((DEPTH, DEC_BATCH, SSM_GROUPS, SSM_STATE), 0.1)
    inp["state_ssm_im"] = nrm((DEPTH, DEC_BATCH, SSM_GROUPS, SSM_STATE), 0.1)
    inp["ffn1_norm_pre"] = gain((DEPTH, D_MODEL))
    inp["ffn1_norm_post"] = gain((DEPTH, D_MODEL))
    inp["ffn1_w_gate"] = nrm((DEPTH, D_MODEL, D_FF), D_MODEL ** -0.5)
    inp["ffn1_w_up"] = nrm((DEPTH, D_MODEL, D_FF), D_MODEL ** -0.5)
    inp["ffn1_w_down"] = nrm((DEPTH, D_FF, D_MODEL), D_FF ** -0.5)
    inp["mix_norm_pre"] = gain((DEPTH, D_MODEL))
    inp["mix_norm_post"] = gain((DEPTH, D_MODEL))
    inp["w_in"] = nrm((DEPTH, D_MODEL, IN_WIDTH), D_MODEL ** -0.5)
    inp["ssm_a_re"] = -0.5 + nrm((DEPTH, SSM_GROUPS, SSM_STATE), 0.01)
    inp["ssm_a_im"] = (math.pi * jnp.arange(SSM_STATE, dtype=f32))[None, None, :] + nrm((DEPTH, SSM_GROUPS, SSM_STATE), 0.01)
    inp["ssm_log_dt"] = jax.random.uniform(next(ks), (DEPTH, SSM_GROUPS), f32, math.log(DT_MIN), math.log(DT_MAX))
    inp["ssm_b_re"] = nrm((DEPTH, SSM_GROUPS, SSM_STATE, SSM_GROUP), (2 * SSM_GROUP) ** -0.5)
    inp["ssm_b_im"] = nrm((DEPTH, SSM_GROUPS, SSM_STATE, SSM_GROUP), (2 * SSM_GROUP) ** -0.5)
    inp["ssm_c_re"] = nrm((DEPTH, SSM_GROUPS, SSM_GROUP, SSM_STATE), SSM_STATE ** -0.5)
    inp["ssm_c_im"] = nrm((DEPTH, SSM_GROUPS, SSM_GROUP, SSM_STATE), SSM_STATE ** -0.5)
    inp["ssm_d"] = nrm((DEPTH, SSM_GROUPS, SSM_GROUP), 1.0)
    inp["ssm_w_glu"] = nrm((DEPTH, SSM_WIDTH, SSM_WIDTH), SSM_WIDTH ** -0.5)
    inp["ssm_b_glu"] = nrm((DEPTH, SSM_WIDTH), 0.01)
    inp["att_rel_bias"] = nrm((DEPTH, ATT_HEADS, 2 * REL_CLIP + 1), 0.5)
    inp["mem_norm"] = gain((DEPTH, D_MODEL))
    inp["w_mem_k"] = nrm((DEPTH, D_MODEL, MEM_WIDTH), D_MODEL ** -0.5)
    inp["w_mem_v"] = nrm((DEPTH, D_MODEL, MEM_WIDTH), D_MODEL ** -0.5)
    inp["w_branch_ssm"] = nrm((DEPTH, SSM_WIDTH, D_MODEL), SSM_WIDTH ** -0.5)
    inp["w_branch_att"] = nrm((DEPTH, ATT_WIDTH, D_MODEL), ATT_WIDTH ** -0.5)
    inp["w_branch_mem"] = nrm((DEPTH, MEM_WIDTH, D_MODEL), MEM_WIDTH ** -0.5)
    inp["w_out"] = nrm((DEPTH, D_MODEL, D_MODEL), D_MODEL ** -0.5)
    inp["ffn2_norm_pre"] = gain((DEPTH, D_MODEL))
    inp["ffn2_norm_post"] = gain((DEPTH, D_MODEL))
    inp["ffn2_w_gate"] = nrm((DEPTH, D_MODEL, D_FF), D_MODEL ** -0.5)
    inp["ffn2_w_up"] = nrm((DEPTH, D_MODEL, D_FF), D_MODEL ** -0.5)
    inp["ffn2_w_down"] = nrm((DEPTH, D_FF, D_MODEL), D_FF ** -0.5)
    return inp


def reference(x_prompt, x_sample, mem_prompt, cache_att_k, cache_att_v, cache_mem_k, cache_mem_v,
              state_ssm_re, state_ssm_im,
              ffn1_norm_pre, ffn1_norm_post, ffn1_w_gate, ffn1_w_up, ffn1_w_down,
              mix_norm_pre, mix_norm_post, w_in,
              ssm_a_re, ssm_a_im, ssm_log_dt, ssm_b_re, ssm_b_im, ssm_c_re, ssm_c_im, ssm_d,
              ssm_w_glu, ssm_b_glu, att_rel_bias, mem_norm, w_mem_k, w_mem_v,
              w_branch_ssm, w_branch_att, w_branch_mem, w_out,
              ffn2_norm_pre, ffn2_norm_post, ffn2_w_gate, ffn2_w_up, ffn2_w_down):
    n_bp, t_p, _ = x_prompt.shape
    keep = min(BAND_PAST, t_p)
    h_p = x_prompt
    h_s = x_sample
    att_k_p, att_v_p, mem_k_p, mem_v_p, ssm_re_p, ssm_im_p = [], [], [], [], [], []
    att_k_s, att_v_s, ssm_re_s, ssm_im_s = [], [], [], []
    for l in range(DEPTH):
        p = {
            "ffn1_norm_pre": ffn1_norm_pre[l], "ffn1_norm_post": ffn1_norm_post[l],
            "ffn1_w_gate": ffn1_w_gate[l], "ffn1_w_up": ffn1_w_up[l], "ffn1_w_down": ffn1_w_down[l],
            "mix_norm_pre": mix_norm_pre[l], "mix_norm_post": mix_norm_post[l], "w_in": w_in[l],
            "ssm_a_re": ssm_a_re[l], "ssm_a_im": ssm_a_im[l], "ssm_log_dt": ssm_log_dt[l],
            "ssm_b_re": ssm_b_re[l], "ssm_b_im": ssm_b_im[l], "ssm_c_re": ssm_c_re[l], "ssm_c_im": ssm_c_im[l],
            "ssm_d": ssm_d[l], "ssm_w_glu": ssm_w_glu[l], "ssm_b_glu": ssm_b_glu[l],
            "att_rel_bias": att_rel_bias[l],
            "w_branch_ssm": w_branch_ssm[l], "w_branch_att": w_branch_att[l], "w_branch_mem": w_branch_mem[l],
            "w_out": w_out[l],
            "ffn2_norm_pre": ffn2_norm_pre[l], "ffn2_norm_post": ffn2_norm_post[l],
            "ffn2_w_gate": ffn2_w_gate[l], "ffn2_w_up": ffn2_w_up[l], "ffn2_w_down": ffn2_w_down[l],
        }
        mk_p, mv_p = memory_kv(mem_prompt, mem_norm[l], w_mem_k[l], w_mem_v[l])
        zero_state = jnp.zeros((n_bp, SSM_GROUPS, SSM_STATE), jnp.float32)
        h_p, k_p, v_p, sr_p, si_p = layer_forward(h_p, p, band_attention_prompt, zero_state, zero_state, mk_p, mv_p)
        att_k_p.append(k_p[:, t_p - keep:])
        att_v_p.append(v_p[:, t_p - keep:])
        mem_k_p.append(mk_p)
        mem_v_p.append(mv_p)
        ssm_re_p.append(sr_p)
        ssm_im_p.append(si_p)
        attn_s = functools.partial(band_attention_sample, k_cache=cache_att_k[l], v_cache=cache_att_v[l])
        h_s, k_s, v_s, sr_s, si_s = layer_forward(h_s, p, attn_s, state_ssm_re[l], state_ssm_im[l],
                                                  cache_mem_k[l], cache_mem_v[l])
        att_k_s.append(k_s)
        att_v_s.append(v_s)
        ssm_re_s.append(sr_s)
        ssm_im_s.append(si_s)
    return (h_p, h_s,
            jnp.stack(att_k_p), jnp.stack(att_v_p), jnp.stack(mem_k_p), jnp.stack(mem_v_p),
            jnp.stack(ssm_re_p), jnp.stack(ssm_im_p),
            jnp.stack(att_k_s), jnp.stack(att_v_s), jnp.stack(ssm_re_s), jnp.stack(ssm_im_s))
```

```cpp
#include <hip/hip_runtime.h>
#include <hip/hip_cooperative_groups.h>
#include <cstdio>
#include <cstdint>
namespace cg = cooperative_groups;

#define LAS __attribute__((address_space(3)))
typedef unsigned short bf16_t;
typedef short bf16x8 __attribute__((ext_vector_type(8)));
typedef short bf16x4 __attribute__((ext_vector_type(4)));
typedef float f32x4 __attribute__((ext_vector_type(4)));
typedef unsigned u32x4 __attribute__((ext_vector_type(4)));
typedef unsigned u32x2 __attribute__((ext_vector_type(2)));

constexpr int D = 2048, MP = 32768, MS = 256, M = MP + MS, FF = 5632, NIN5 = 5120, NGATE = 6144, TP = 4096;
constexpr float EPS = 1e-6f;
constexpr int SEG = 256, NSEG = TP / SEG;
constexpr size_t O_Y = 0;
constexpr size_t O_ATTK_P = (size_t)M * D;
constexpr size_t O_ATTV_P = O_ATTK_P + 4194304;
constexpr size_t O_MEMK_P = O_ATTV_P + 4194304;
constexpr size_t O_MEMV_P = O_MEMK_P + 2097152;
constexpr size_t O_SRE_P = O_MEMV_P + 2097152;
constexpr size_t O_SIM_P = O_SRE_P + 32768;
constexpr size_t O_ATTK_S = O_SIM_P + 32768;
constexpr size_t O_ATTV_S = O_ATTK_S + 262144;
constexpr size_t O_SRE_S = O_ATTV_S + 262144;
constexpr size_t O_SIM_S = O_SRE_S + 65536;
constexpr size_t MiB = 1u << 20;
constexpr size_t WS_WGU1 = 1 * MiB, WS_WD1 = 45 * MiB, WS_WIN = 67 * MiB, WS_WGLU = 111 * MiB, WS_WMKV = 113 * MiB, WS_WBR = 121 * MiB,
                 WS_WOUT = 133 * MiB, WS_WGU2 = 141 * MiB, WS_WD2 = 185 * MiB;
constexpr size_t WS_YS = 1 * MiB;
constexpr size_t WS_U = 207 * MiB;
constexpr size_t WS_BIG = 336 * MiB;
constexpr size_t WS_YO = 723 * MiB;
constexpr size_t WS_MN = 917 * MiB, WS_MKV = 925 * MiB, WS_CK = 933 * MiB, WS_CV = 949 * MiB, WS_CMK = 965 * MiB, WS_CMV = 973 * MiB;
constexpr size_t WS_RSQ = 981 * MiB;
constexpr size_t WS_SE = 986 * MiB;
constexpr size_t WS_SAB = 990 * MiB;
constexpr size_t WS_SBB = 990 * MiB + 65536;
constexpr size_t WS_SCM = 990 * MiB + 65536 + 262144;
constexpr size_t WS_MVT = 992 * MiB;
constexpr size_t WS_CMVT = 996 * MiB;
constexpr size_t WS_ZS = 691 * MiB;
constexpr size_t WS_END = 1004 * MiB;
constexpr int LDS_BYTES = 147456;
constexpr int WLDS = 16384;

__device__ __forceinline__ unsigned cvt_pk_bf16(float lo, float hi) { unsigned r; asm volatile("s_nop 1\n\tv_cvt_pk_bf16_f32 %0, %1, %2\n\ts_nop 0" : "=v"(r) : "v"(lo), "v"(hi)); return r; }
__device__ __forceinline__ float bf2f(unsigned b) { return __uint_as_float(b << 16); }
__device__ __forceinline__ float bflo(unsigned w) { return __uint_as_float(w << 16); }
__device__ __forceinline__ float bfhi(unsigned w) { return __uint_as_float(w & 0xffff0000u); }
__device__ __forceinline__ float wave_sum(float v) {
#pragma unroll
    for (int o = 1; o < 64; o <<= 1) v += __shfl_xor(v, o);
    return v;
}
__device__ __forceinline__ float sigmoidf_(float x) { return __builtin_amdgcn_rcpf(1.0f + __expf(-x)); }
#define LDS_WAIT() asm volatile("s_waitcnt lgkmcnt(0)" ::: "memory")
__device__ __forceinline__ int lane_id() { int l; asm volatile("v_mbcnt_lo_u32_b32 %0, -1, 0\n\tv_mbcnt_hi_u32_b32 %0, -1, %0" : "=v"(l)); return l; }

namespace pg8 {
constexpr int BM = 256, BK = 64, HALF = 128, HTB = HALF * BK * 2, STAGE_BYTES = 8 * HTB, NXCD = 8, WGM = 8;
__host__ __device__ __forceinline__ int lds_byte(int r, int c) { const int st = (r >> 4) * 2 + (c >> 5), rr = r & 15, cc = c & 31, ob = rr * 64 + cc * 2; return st * 1024 + (ob ^ (((ob >> 9) & 1) << 5)); }
__host__ __device__ __forceinline__ void stage_rc(int b, int& R, int& C) { const int st = b / 1024, sb = b % 1024, swz = sb ^ (((sb >> 9) & 1) << 5); R = (st >> 1) * 16 + swz / 64; C = (st & 1) * 32 + (swz % 64) / 2; }
__host__ __device__ __forceinline__ int perm32(int rho) { const int n = rho >> 4, i = rho & 15; return 8 * (i >> 2) + 4 * n + (i & 3); }

struct Unit { int pm, pn, z; };
struct Gemm { const bf16_t* A; const bf16_t* Bt; int K; size_t zsA, zsB; int ld; };

struct Sched {
    int nM, nN, nwg, G, c, Z;
    __device__ void init(int M_, int N_, int G_, int c_, int Z_) { nM = M_ / BM; nN = N_ / BM; nwg = nM * nN; G = G_; c = c_; Z = Z_; }
    __device__ bool next(int i, Unit& u) const {
        int z = 0, ii = i;
        if (Z > 1) { z = i % Z; ii = i / Z; }
        const long L = (long)ii * G + c; if (L >= nwg) return false;
        int wgid = (int)L; { const int q = nwg / NXCD, r = nwg % NXCD, xcd = wgid % NXCD, off = wgid / NXCD; wgid = (xcd < r ? xcd * (q + 1) : r * (q + 1) + (xcd - r) * q) + off; }
        const int nig = WGM * nN, gid = wgid / nig, fm = gid * WGM, gsz = (nM - fm) < WGM ? (nM - fm) : WGM;
        u.pm = fm + ((wgid % nig) % gsz); u.pn = (wgid % nig) / gsz; u.z = z; return true;
    }
};

template <class Epi, class SchedT>
__device__ __forceinline__ void gemm_phase(LAS unsigned char* lds, const Gemm g, const SchedT& S, const Epi& E, const int wid) {
    const int lane = lane_id(), tid = wid * 64 + lane, wr = wid >> 2, wc = wid & 3, fr = lane & 15, fq = lane >> 4;
    const int K = g.K, nt = K / BK, ld = g.ld ? g.ld : g.K;
    unsigned voffA[2], voffB[2];
#pragma unroll
    for (int i = 0; i < 2; ++i) { int R, C; stage_rc(tid * 16 + i * 8192, R, C); const int Rb = (R & ~31) + perm32(R & 31);
        voffA[i] = (unsigned)(R * ld + C) * 2u; voffB[i] = (unsigned)(Rb * ld + C) * 2u; }
    const size_t kstep = (size_t)(BK * 2);
    const size_t hstep = (size_t)HALF * ld * 2;
    const size_t tstep = 2 * hstep;
    const unsigned ldsw = (unsigned)wid * 1024u;
    const int aoff = lds_byte(wr * 64 + fr, fq * 8), boff = lds_byte(wc * 32 + fr, fq * 8);
#define PG8_SA(b, h) (((b) * 2 + (h)) * HTB)
#define PG8_SB(b, h) ((4 + (b) * 2 + (h)) * HTB)
#define PG8_STAGE(bufoff, gbase, voff) do { _Pragma("unroll") for (int _i = 0; _i < 2; ++_i) \
        __builtin_amdgcn_global_load_lds((const unsigned*)((const char*)(gbase) + (voff)[_i]), (LAS unsigned*)(lds + (bufoff) + ldsw + _i * 8192), 16, 0, 0); } while (0)
#define PG8_LDA(dst, b, h) do { _Pragma("unroll") for (int m = 0; m < 4; ++m) _Pragma("unroll") for (int k = 0; k < 2; ++k) dst[m][k] = *(const LAS bf16x8*)(lds + PG8_SA(b, h) + aoff + m * 2048 + k * 1024); } while (0)
#define PG8_LDB(dst, b, h) do { _Pragma("unroll") for (int n = 0; n < 2; ++n) _Pragma("unroll") for (int k = 0; k < 2; ++k) dst[n][k] = *(const LAS bf16x8*)(lds + PG8_SB(b, h) + boff + n * 2048 + k * 1024); } while (0)
#define PG8_MMA(ai, bj, At, Bt) do { __builtin_amdgcn_s_setprio(1); _Pragma("unroll") for (int m = 0; m < 4; ++m) _Pragma("unroll") for (int n = 0; n < 2; ++n) _Pragma("unroll") for (int k = 0; k < 2; ++k) \
        acc[ai][bj][m][n] = __builtin_amdgcn_mfma_f32_16x16x32_bf16(Bt[n][k], At[m][k], acc[ai][bj][m][n], 0, 0, 0); __builtin_amdgcn_s_setprio(0); } while (0)
#define PG8_WAIT_V(n) asm volatile("s_waitcnt vmcnt(" #n ")" ::: "memory")
#define PG8_WAIT_L(n) asm volatile("s_waitcnt lgkmcnt(" #n ")" ::: "memory")
#define PG8_BAR __builtin_amdgcn_s_barrier()
#define PG8_SCHED __builtin_amdgcn_sched_barrier(0)
    Unit cur, nxt; int ui = 0;
    if (!S.next(0, cur)) return;
    f32x4 acc[2][2][4][2];
#pragma unroll
    for (int a = 0; a < 2; ++a)
#pragma unroll
        for (int b = 0; b < 2; ++b)
#pragma unroll
            for (int m = 0; m < 4; ++m)
#pragma unroll
                for (int n = 0; n < 2; ++n) acc[a][b][m][n] = (f32x4){0.f, 0.f, 0.f, 0.f};
    bf16x8 At[4][2], B0[2][2], B1[2][2];
    const char* cA = (const char*)g.A + (size_t)cur.z * g.zsA + (size_t)cur.pm * tstep; const char* cB = (const char*)g.Bt + (size_t)cur.z * g.zsB + (size_t)cur.pn * tstep;
    PG8_STAGE(PG8_SB(0, 0), cB, voffB); PG8_STAGE(PG8_SB(0, 1), cB + hstep, voffB); PG8_STAGE(PG8_SA(0, 0), cA, voffA); PG8_STAGE(PG8_SA(0, 1), cA + hstep, voffA);
    if (wr == 1) PG8_BAR;
    PG8_WAIT_V(2); PG8_BAR;
    PG8_STAGE(PG8_SB(1, 0), cB + kstep, voffB); PG8_STAGE(PG8_SA(1, 0), cA + kstep, voffA); PG8_STAGE(PG8_SB(1, 1), cB + hstep + kstep, voffB);
    PG8_WAIT_V(6); PG8_BAR;
    for (;;) {
        const bool has_next = S.next(ui + 1, nxt);
        const char* nA = has_next ? (const char*)g.A + (size_t)nxt.z * g.zsA + (size_t)nxt.pm * tstep : cA; const char* nB = has_next ? (const char*)g.Bt + (size_t)nxt.z * g.zsB + (size_t)nxt.pn * tstep : cB;
        for (int t = 0; t < nt; t += 2) {
            const bool last = (t == nt - 2);
            const char* a1 = cA + (size_t)(t + 1) * kstep;
            const char* a2 = last ? nA : cA + (size_t)(t + 2) * kstep; const char* b2 = last ? nB : cB + (size_t)(t + 2) * kstep;
            const char* a3 = a2 + kstep; const char* b3 = b2 + kstep;
            PG8_LDB(B0, 0, 0); PG8_LDB(B1, 0, 1); PG8_SCHED; PG8_LDA(At, 0, 0); PG8_STAGE(PG8_SA(1, 1), a1 + hstep, voffA);
            PG8_WAIT_V(8); PG8_WAIT_L(0); PG8_BAR; PG8_MMA(0, 0, At, B0); PG8_MMA(0, 1, At, B1); PG8_BAR; PG8_SCHED;
            PG8_LDA(At, 0, 1); PG8_STAGE(PG8_SB(0, 0), b2, voffB); PG8_STAGE(PG8_SB(0, 1), b2 + hstep, voffB); PG8_STAGE(PG8_SA(0, 0), a2, voffA);
            PG8_WAIT_V(8); PG8_WAIT_L(0); PG8_BAR; PG8_MMA(1, 0, At, B0); PG8_MMA(1, 1, At, B1); PG8_BAR; PG8_SCHED;
            PG8_LDB(B0, 1, 0); PG8_LDB(B1, 1, 1); PG8_SCHED; PG8_LDA(At, 1, 0); PG8_STAGE(PG8_SA(0, 1), a2 + hstep, voffA);
            PG8_WAIT_V(8); PG8_WAIT_L(0); PG8_BAR; PG8_MMA(0, 0, At, B0); PG8_MMA(0, 1, At, B1); PG8_BAR; PG8_SCHED;
            PG8_LDA(At, 1, 1); PG8_STAGE(PG8_SB(1, 0), b3, voffB); PG8_STAGE(PG8_SB(1, 1), b3 + hstep, voffB); PG8_STAGE(PG8_SA(1, 0), a3, voffA);
            PG8_WAIT_V(8); PG8_WAIT_L(0); PG8_BAR; PG8_MMA(1, 0, At, B0); PG8_MMA(1, 1, At, B1); PG8_BAR; PG8_SCHED;
        }
        if (wr == 0) PG8_BAR;
        E(acc, cur, wr, wc, fr, fq);
        if (!has_next) break;
#pragma unroll
        for (int a = 0; a < 2; ++a)
#pragma unroll
            for (int b = 0; b < 2; ++b)
#pragma unroll
                for (int m = 0; m < 4; ++m)
#pragma unroll
                    for (int n = 0; n < 2; ++n) acc[a][b][m][n] = (f32x4){0.f, 0.f, 0.f, 0.f};
        cur = nxt; cA = nA; cB = nB; ++ui;
        if (wr == 1) PG8_BAR;
    }
    PG8_WAIT_V(0);
    PG8_BAR;
#undef PG8_SA
#undef PG8_SB
#undef PG8_STAGE
#undef PG8_LDA
#undef PG8_LDB
#undef PG8_MMA
#undef PG8_WAIT_V
#undef PG8_WAIT_L
#undef PG8_BAR
#undef PG8_SCHED
}

struct SchedSplit {
    int nN, S, G, c;
    __device__ bool next(int i, Unit& u) const { const int L = i * G + c; if (L >= nN * S) return false; u.pm = 0; u.pn = L % nN; u.z = L / nN; return true; }
};
typedef const f32x4 (&AccRef)[2][2][4][2];
__device__ __forceinline__ u32x4 pack8(const f32x4 a, const f32x4 b) { u32x4 w; w.x = cvt_pk_bf16(a[0], a[1]); w.y = cvt_pk_bf16(a[2], a[3]); w.z = cvt_pk_bf16(b[0], b[1]); w.w = cvt_pk_bf16(b[2], b[3]); return w; }

struct EpiSwiglu {
    bf16_t* ACT;
    __device__ __forceinline__ void operator()(AccRef acc, const Unit& u, int wr, int wc, int fr, int fq) const {
        const int row0 = u.pm * BM + wr * 64 + fr, col = u.pn * 128 + wc * 32 + 8 * fq;
#pragma unroll
        for (int ai = 0; ai < 2; ++ai)
#pragma unroll
            for (int m = 0; m < 4; ++m) {
                f32x4 r0, r1;
#pragma unroll
                for (int j = 0; j < 4; ++j) { const float g0 = acc[ai][0][m][0][j], g1 = acc[ai][0][m][1][j];
                    r0[j] = g0 * sigmoidf_(g0) * acc[ai][1][m][0][j]; r1[j] = g1 * sigmoidf_(g1) * acc[ai][1][m][1][j]; }
                *(u32x4*)(ACT + (size_t)(row0 + ai * HALF + m * 16) * FF + col) = pack8(r0, r1);
            }
    }
};
struct EpiDown {
    bf16_t* Y; float* RSQ;
    __device__ __forceinline__ void operator()(AccRef acc, const Unit& u, int wr, int wc, int fr, int fq) const {
        const int row0 = u.pm * BM + wr * 64 + fr, col = u.pn * BM + wc * 32 + 8 * fq;
#pragma unroll
        for (int ai = 0; ai < 2; ++ai)
#pragma unroll
            for (int m = 0; m < 4; ++m) { const int row = row0 + ai * HALF + m * 16; float s = 0.f;
#pragma unroll
                for (int bj = 0; bj < 2; ++bj) { const f32x4 a = acc[ai][bj][m][0], b = acc[ai][bj][m][1];
                    s += (a[0] * a[0] + a[1] * a[1]) + (a[2] * a[2] + a[3] * a[3]) + (b[0] * b[0] + b[1] * b[1]) + (b[2] * b[2] + b[3] * b[3]);
                    *(u32x4*)(Y + (size_t)row * D + col + bj * HALF) = pack8(a, b); }
                s += __shfl_xor(s, 16); s += __shfl_xor(s, 32);
                if (fq == 0) RSQ[(size_t)row * 32 + u.pn * 4 + wc] = s; }
    }
};
struct EpiSplitAcc {
    float* ZS;
    __device__ __forceinline__ void operator()(AccRef acc, const Unit& u, int wr, int wc, int fr, int fq) const {
        const int row0 = wr * 64 + fr, col = u.pn * BM + wc * 32 + 8 * fq;
#pragma unroll
        for (int ai = 0; ai < 2; ++ai)
#pragma unroll
            for (int m = 0; m < 4; ++m) { float* rp = ZS + (size_t)(row0 + ai * HALF + m * 16) * D + col;
#pragma unroll
                for (int bj = 0; bj < 2; ++bj)
#pragma unroll
                    for (int n = 0; n < 2; ++n) *(f32x4*)(rp + (size_t)u.z * 256 * D + bj * HALF + 4 * n) = acc[ai][bj][m][n]; }
    }
};
struct EpiWin {
    bf16_t* PROJ; float* out;
    __device__ __forceinline__ void operator()(AccRef acc, const Unit& u, int wr, int wc, int fr, int fq) const {
        const int row0 = u.pm * BM + wr * 64 + fr, col = u.pn * BM + wc * 32 + 8 * fq;
        const bool kv = (u.pn >= 8 && u.pn < 16), isk = u.pn < 12, samp = (u.pm == 128), tailp = (!samp && (u.pm & 15) >= 14);
        const int kcol0 = col - (isk ? 2048 : 3072);
#pragma unroll
        for (int ai = 0; ai < 2; ++ai)
#pragma unroll
            for (int m = 0; m < 4; ++m) { const int row = row0 + ai * HALF + m * 16;
#pragma unroll
                for (int bj = 0; bj < 2; ++bj) { const f32x4 a = acc[ai][bj][m][0], b = acc[ai][bj][m][1];
                    *(u32x4*)(PROJ + (size_t)row * NIN5 + col + bj * HALF) = pack8(a, b);
                    if (kv && (samp || tailp)) {
                        float* dst;
                        if (samp) dst = out + (isk ? O_ATTK_S : O_ATTV_S) + (size_t)(row - MP) * 1024 + kcol0 + bj * HALF;
                        else { const int bb = row >> 12, t = row & 4095; dst = out + (isk ? O_ATTK_P : O_ATTV_P) + (size_t)(bb * 512 + t - 3584) * 1024 + kcol0 + bj * HALF; }
                        *(f32x4*)dst = a; *(f32x4*)(dst + 4) = b; } } }
    }
};
struct EpiMemKV {
    bf16_t* MKV; float* out;
    __device__ __forceinline__ void operator()(AccRef acc, const Unit& u, int wr, int wc, int fr, int fq) const {
        const int row0 = u.pm * BM + wr * 64 + fr, col = u.pn * BM + wc * 32 + 8 * fq;
        const bool isk = u.pn < 4; float* ob = out + (isk ? O_MEMK_P : O_MEMV_P) + (col - (isk ? 0 : 1024));
#pragma unroll
        for (int ai = 0; ai < 2; ++ai)
#pragma unroll
            for (int m = 0; m < 4; ++m) { const int row = row0 + ai * HALF + m * 16;
#pragma unroll
                for (int bj = 0; bj < 2; ++bj) { const f32x4 a = acc[ai][bj][m][0], b = acc[ai][bj][m][1];
                    *(u32x4*)(MKV + (size_t)row * 2048 + col + bj * HALF) = pack8(a, b);
                    float* dst = ob + (size_t)row * 1024 + bj * HALF; *(f32x4*)dst = a; *(f32x4*)(dst + 4) = b; } }
    }
};
struct EpiGate {
    bf16_t* G;
    __device__ __forceinline__ void operator()(AccRef acc, const Unit& u, int wr, int wc, int fr, int fq) const {
        const int row0 = u.pm * BM + wr * 64 + fr, col = u.pn * BM + wc * 32 + 8 * fq;
#pragma unroll
        for (int ai = 0; ai < 2; ++ai)
#pragma unroll
            for (int m = 0; m < 4; ++m) { const int row = row0 + ai * HALF + m * 16;
#pragma unroll
                for (int bj = 0; bj < 2; ++bj) { const f32x4 a = acc[ai][bj][m][0], b = acc[ai][bj][m][1];
                    *(u32x4*)(G + (size_t)row * NGATE + col + bj * HALF) = pack8(a, b); } }
    }
};
__device__ __forceinline__ void unpack8(const u32x4 w, f32x4& a, f32x4& b) { a[0] = bflo(w.x); a[1] = bfhi(w.x); a[2] = bflo(w.y); a[3] = bfhi(w.y); b[0] = bflo(w.z); b[1] = bfhi(w.z); b[2] = bflo(w.w); b[3] = bfhi(w.w); }
struct EpiGlu {
    const bf16_t* YS; const float* bias; bf16_t* OS;
    __device__ __forceinline__ void operator()(AccRef acc, const Unit& u, int wr, int wc, int fr, int fq) const {
        const int row0 = u.pm * BM + wr * 64 + fr, col = u.pn * BM + wc * 32 + 8 * fq;
#pragma unroll
        for (int ai = 0; ai < 2; ++ai)
#pragma unroll
            for (int m = 0; m < 4; ++m) { const int row = row0 + ai * HALF + m * 16;
#pragma unroll
                for (int bj = 0; bj < 2; ++bj) { f32x4 a = acc[ai][bj][m][0], b = acc[ai][bj][m][1];
                    const size_t off = (size_t)row * 1024 + col + bj * HALF;
                    const f32x4 b0 = *(const f32x4*)(bias + col + bj * HALF), b1 = *(const f32x4*)(bias + col + bj * HALF + 4);
                    f32x4 y0, y1; unpack8(*(const volatile u32x4*)(YS + off), y0, y1);
#pragma unroll
                    for (int j = 0; j < 4; ++j) { a[j] = y0[j] * sigmoidf_(a[j] + b0[j]); b[j] = y1[j] * sigmoidf_(b[j] + b1[j]); }
                    *(u32x4*)(OS + off) = pack8(a, b); } }
    }
};
struct EpiBranch {
    const bf16_t* G; bf16_t* MG;
    __device__ __forceinline__ void operator()(AccRef acc, const Unit& u, int wr, int wc, int fr, int fq) const {
        const int row0 = u.pm * BM + wr * 64 + fr, col = u.pn * BM + wc * 32 + 8 * fq;
#pragma unroll
        for (int ai = 0; ai < 2; ++ai)
#pragma unroll
            for (int m = 0; m < 4; ++m) { const int row = row0 + ai * HALF + m * 16;
#pragma unroll
                for (int bj = 0; bj < 2; ++bj) { f32x4 a = acc[ai][bj][m][0], b = acc[ai][bj][m][1];
                    f32x4 g0, g1; unpack8(*(const volatile u32x4*)(G + (size_t)row * NGATE + u.z * 2048 + col + bj * HALF), g0, g1);
                    bf16_t* mp = MG + (size_t)row * D + col + bj * HALF;
#pragma unroll
                    for (int j = 0; j < 4; ++j) { a[j] = a[j] * sigmoidf_(g0[j]); b[j] = b[j] * sigmoidf_(g1[j]); }
                    if (u.z > 0) { f32x4 o0, o1; unpack8(*(const volatile u32x4*)mp, o0, o1); a = a + o0; b = b + o1; }
                    *(volatile u32x4*)mp = pack8(a, b); } }
    }
};
}

struct Params { const float* in[40]; float* out; unsigned char* ws; int ph_lo, ph_hi; };
enum { I_XP = 0, I_XS, I_MEMP, I_CAK, I_CAV, I_CMK, I_CMV, I_SRE, I_SIM, I_F1PRE, I_F1POST, I_F1G, I_F1U, I_F1D, I_MIXPRE, I_MIXPOST, I_WIN,
       I_SARE, I_SAIM, I_SLDT, I_SBRE, I_SBIM, I_SCRE, I_SCIM, I_SD, I_SWGLU, I_SBGLU, I_RELB, I_MEMNORM, I_WMK, I_WMV, I_WBS, I_WBA, I_WBM, I_WOUT,
       I_F2PRE, I_F2POST, I_F2G, I_F2U, I_F2D };

__device__ __forceinline__ void tr_item(const float* W, int K, int N, bf16_t* WT, int row_off, int inter, LAS float* scr, int item, int lane) {
    const int nblk = N / 32, kb = item / nblk, nb = item % nblk, k0 = 64 * kb, n0 = 32 * nb;
#pragma unroll 8
    for (int i = 0; i < 32; ++i) { const int kk = 2 * i + (lane >> 5); scr[kk * 33 + (lane & 31)] = W[(size_t)(k0 + kk) * N + n0 + (lane & 31)]; }
    LDS_WAIT();
    const int c = lane & 7;
#pragma unroll
    for (int j = 0; j < 4; ++j) { const int n = (lane >> 3) + 8 * j; const LAS float* s = scr + (8 * c) * 33 + n;
        u32x4 o; o.x = cvt_pk_bf16(s[0 * 33], s[1 * 33]); o.y = cvt_pk_bf16(s[2 * 33], s[3 * 33]); o.z = cvt_pk_bf16(s[4 * 33], s[5 * 33]); o.w = cvt_pk_bf16(s[6 * 33], s[7 * 33]);
        const int col = n0 + n; const int drow = inter ? (((col >> 7) << 8) + (col & 127) + row_off) : (row_off + col);
        *(u32x4*)(WT + (size_t)drow * K + k0 + 8 * c) = o; }
    LDS_WAIT();
}
__device__ __forceinline__ void rms_row_to_bf16(const float* xrow, const float* gain, bf16_t* orow, int lane) {
    f32x4 v[8]; float s = 0.f;
#pragma unroll
    for (int j = 0; j < 8; ++j) { v[j] = *(const f32x4*)(xrow + 4 * lane + 256 * j); s += (v[j][0] * v[j][0] + v[j][1] * v[j][1]) + (v[j][2] * v[j][2] + v[j][3] * v[j][3]); }
    const float rs = rsqrtf(wave_sum(s) * (1.0f / D) + EPS);
#pragma unroll
    for (int j = 0; j < 8; ++j) { const f32x4 gg = *(const f32x4*)(gain + 4 * lane + 256 * j);
        u32x2 w; w.x = cvt_pk_bf16(v[j][0] * rs * gg[0], v[j][1] * rs * gg[1]); w.y = cvt_pk_bf16(v[j][2] * rs * gg[2], v[j][3] * rs * gg[3]);
        *(u32x2*)(orow + 4 * lane + 256 * j) = w; }
}
__device__ __forceinline__ void cvt_copy(const float* src, bf16_t* dst, size_t n, int gw, int NGW, int lane) {
    for (size_t i = ((size_t)gw * 64 + lane) * 8; i < n; i += (size_t)NGW * 512) {
        const f32x4 a = *(const f32x4*)(src + i), b = *(const f32x4*)(src + i + 4);
        *(u32x4*)(dst + i) = pg8::pack8(a, b); }
}


__device__ __forceinline__ int vpos_of(int key) { return (key >> 5) * 32 + ((key >> 2) & 3) * 8 + ((key >> 4) & 1) * 4 + (key & 3); }
template <class T> __device__ __forceinline__ void mvt_build(const T* src, int spitch, int scol0, bf16_t* dst, int nb, size_t gtid, size_t nthr) {
    for (size_t idx = gtid; idx < (size_t)nb * 4096; idx += nthr) {
        const int d = (int)(idx & 63), dc = (int)((idx >> 6) & 3), kb = (int)((idx >> 8) & 3), h = (int)((idx >> 10) & 3), b = (int)(idx >> 12);
        const T* sp = src + ((size_t)b * 256 + kb * 64) * spitch + scol0 + h * 256 + dc * 64 + d;
        bf16_t* dp = dst + ((((size_t)(b * 4 + h) * 4 + kb) * 4 + dc) * 64 + d) * 64;
#pragma unroll
        for (int c = 0; c < 8; ++c) { const int t = c >> 2, g = c & 3; float v[8];
#pragma unroll
            for (int i = 0; i < 8; ++i) { const int key = 32 * t + 16 * (i >> 2) + 4 * g + (i & 3);
                if constexpr (sizeof(T) == 4) v[i] = (float)sp[(size_t)key * spitch]; else v[i] = bf2f(sp[(size_t)key * spitch]); }
            u32x4 w; w.x = cvt_pk_bf16(v[0], v[1]); w.y = cvt_pk_bf16(v[2], v[3]); w.z = cvt_pk_bf16(v[4], v[5]); w.w = cvt_pk_bf16(v[6], v[7]);
            *(u32x4*)(dp + 8 * c) = w; }
    }
}

template <int MODE>
__device__ __forceinline__ void ew_phase(const Params& p, const float* gpost, const float* gpre, int gw, int NGW, int lane, int nsplit) {
    float* H = p.out; const bf16_t* Y = (const bf16_t*)(p.ws + WS_YO); const float* RSQ = (const float*)(p.ws + WS_RSQ); bf16_t* U = (bf16_t*)(p.ws + WS_U);
    const float c = (MODE == 2) ? 1.0f : 0.5f;
    for (int row = gw; row < M; row += NGW) {
        const float* hin = (MODE == 1) ? (row < MP ? p.in[I_XP] + (size_t)row * D : p.in[I_XS] + (size_t)(row - MP) * D) : H + (size_t)row * D;
        f32x4 yv[8]; float part = 0.f;
        if (row < MP) {
            part = lane < 32 ? *(const volatile float*)(RSQ + (size_t)row * 32 + lane) : 0.f;
#pragma unroll
            for (int j = 0; j < 8; ++j) { const u32x2 yw = *(const volatile u32x2*)(Y + (size_t)row * D + 4 * lane + 256 * j); yv[j] = (f32x4){bflo(yw.x), bfhi(yw.x), bflo(yw.y), bfhi(yw.y)}; }
        } else {
            const float* zr = (const float*)(p.ws + WS_ZS) + (size_t)(row - MP) * D;
#pragma unroll
            for (int j = 0; j < 8; ++j) { f32x4 a = (f32x4){0.f, 0.f, 0.f, 0.f};
                for (int sl = 0; sl < nsplit; ++sl) { const u32x4 t = *(const volatile u32x4*)(zr + (size_t)sl * 256 * D + 4 * lane + 256 * j); a[0] += __uint_as_float(t.x); a[1] += __uint_as_float(t.y); a[2] += __uint_as_float(t.z); a[3] += __uint_as_float(t.w); }
                yv[j] = a; part += (a[0] * a[0] + a[1] * a[1]) + (a[2] * a[2] + a[3] * a[3]); }
        }
        const float rs = rsqrtf(wave_sum(part) * (1.0f / D) + EPS) * c;
        f32x4 hv[8]; float ss = 0.f;
#pragma unroll
        for (int j = 0; j < 8; ++j) { const int col = 4 * lane + 256 * j;
            const f32x4 h4 = *(const f32x4*)(hin + col); const f32x4 g4 = *(const f32x4*)(gpost + col);
            f32x4 hn; hn[0] = h4[0] + yv[j][0] * rs * g4[0]; hn[1] = h4[1] + yv[j][1] * rs * g4[1]; hn[2] = h4[2] + yv[j][2] * rs * g4[2]; hn[3] = h4[3] + yv[j][3] * rs * g4[3];
            hv[j] = hn; ss += (hn[0] * hn[0] + hn[1] * hn[1]) + (hn[2] * hn[2] + hn[3] * hn[3]);
            *(f32x4*)(H + (size_t)row * D + col) = hn; }
        if (MODE != 3) {
            const float rs2 = rsqrtf(wave_sum(ss) * (1.0f / D) + EPS);
#pragma unroll
            for (int j = 0; j < 8; ++j) { const int col = 4 * lane + 256 * j; const f32x4 gg = *(const f32x4*)(gpre + col);
                u32x2 w; w.x = cvt_pk_bf16(hv[j][0] * rs2 * gg[0], hv[j][1] * rs2 * gg[1]); w.y = cvt_pk_bf16(hv[j][2] * rs2 * gg[2], hv[j][3] * rs2 * gg[3]);
                *(u32x2*)(U + (size_t)row * D + col) = w; }
        }
    }
}

template <int NQ, int HD, bool BIAS, bool VTG>
__device__ __forceinline__ void attn_item(const bf16_t* Q, int qpitch, const bf16_t* K0, const bf16_t* V0, size_t kbstride, int pitch, int nreg,
                                          const bf16_t* Ks, const bf16_t* Vs, int pitch_s, int nvalid_s, bool has_s,
                                          int qpos0, int kpos_base, float scale, const float* bias_g, bf16_t* O, int opitch, LAS unsigned char* wl, int lane, const bf16_t* VT = nullptr) {
    const int fr = lane & 15, g = lane >> 4;
    LAS float* bl = (LAS float*)(wl + 9216);
    LAS bf16_t* vt = (LAS bf16_t*)wl;
    if (BIAS) { for (int i = lane; i < 257; i += 64) bl[i] = bias_g[i]; }
    bf16x8 qf[NQ][HD / 32];
#pragma unroll
    for (int nq = 0; nq < NQ; ++nq)
#pragma unroll
        for (int kd = 0; kd < HD / 32; ++kd) qf[nq][kd] = *(const bf16x8*)(Q + (size_t)(16 * nq + fr) * qpitch + 32 * kd + 8 * g);
    float mrow[NQ], lrow[NQ]; f32x4 o[HD / 16][NQ];
#pragma unroll
    for (int nq = 0; nq < NQ; ++nq) { mrow[nq] = -1e30f; lrow[nq] = 0.f;
#pragma unroll
        for (int md = 0; md < HD / 16; ++md) o[md][nq] = (f32x4){0.f, 0.f, 0.f, 0.f}; }
    LDS_WAIT();
    const int nkb = nreg + (has_s ? 1 : 0);
    const int vpos = (lane >> 5) * 32 + ((lane >> 2) & 3) * 8 + ((lane >> 4) & 1) * 4 + (lane & 3);
    for (int kb = 0; kb < nkb; ++kb) {
        const bool sp = kb >= nreg;
        const bf16_t* Kp = sp ? Ks : K0 + (size_t)kb * kbstride; const bf16_t* Vp = sp ? Vs : V0 + (size_t)kb * kbstride;
        const int pt = sp ? pitch_s : pitch, nv = sp ? nvalid_s : 64;
        f32x4 st[4][NQ];
#pragma unroll
        for (int mk = 0; mk < 4; ++mk) {
#pragma unroll
            for (int nq = 0; nq < NQ; ++nq) st[mk][nq] = (f32x4){0.f, 0.f, 0.f, 0.f};
            const bool kok = (16 * mk + fr) < nv;
#pragma unroll
            for (int kd = 0; kd < HD / 32; ++kd) {
                bf16x8 kf = (bf16x8){0, 0, 0, 0, 0, 0, 0, 0};
                if (kok) kf = *(const bf16x8*)(Kp + (size_t)(16 * mk + fr) * pt + 32 * kd + 8 * g);
#pragma unroll
                for (int nq = 0; nq < NQ; ++nq) st[mk][nq] = __builtin_amdgcn_mfma_f32_16x16x32_bf16(kf, qf[nq][kd], st[mk][nq], 0, 0, 0);
            }
        }
        __builtin_amdgcn_sched_barrier(0); asm volatile("s_nop 15" ::: "memory"); __builtin_amdgcn_sched_barrier(0);
        constexpr int NPRE = (NQ == 4) ? 4 : 8;
        u32x4 vpre[8];
        if (!VTG && HD == 64) { const bool kvok0 = lane < nv; const bf16_t* vrow0 = Vp + (size_t)lane * pt;
#pragma unroll
            for (int cch = 0; cch < NPRE; ++cch) { vpre[cch] = (u32x4){0u, 0u, 0u, 0u}; if (kvok0) vpre[cch] = *(const u32x4*)(vrow0 + 8 * cch); } }
        const bool farb = BIAS && (qpos0 - (kpos_base + 64 * kb + 63) >= 128);
        const float bfar = BIAS ? bl[256] : 0.f;
        bf16x8 pb[2][NQ];
#pragma unroll
        for (int nq = 0; nq < NQ; ++nq) {
            const int qpos = qpos0 + 16 * nq + fr;
            float mx = -1e30f;
#pragma unroll
            for (int mk = 0; mk < 4; ++mk)
#pragma unroll
                for (int j = 0; j < 4; ++j) { const int key = 16 * mk + 4 * g + j; float s = st[mk][nq][j] * scale;
                    if (BIAS) { if (farb) s += bfar; else { int dd = qpos - (kpos_base + 64 * kb + key); dd = dd < -128 ? -128 : (dd > 128 ? 128 : dd); s += bl[dd + 128]; } }
                    if (key >= nv) s = -1e30f;
                    st[mk][nq][j] = s; mx = fmaxf(mx, s); }
            mx = fmaxf(mx, __shfl_xor(mx, 16)); mx = fmaxf(mx, __shfl_xor(mx, 32));
            const float mnew = fmaxf(mrow[nq], mx), alpha = __expf(mrow[nq] - mnew);
            float ps = 0.f;
#pragma unroll
            for (int mk = 0; mk < 4; ++mk)
#pragma unroll
                for (int j = 0; j < 4; ++j) { const float pv = __expf(st[mk][nq][j] - mnew); st[mk][nq][j] = pv; ps += pv; }
            ps += __shfl_xor(ps, 16); ps += __shfl_xor(ps, 32);
            lrow[nq] = lrow[nq] * alpha + ps; mrow[nq] = mnew;
#pragma unroll
            for (int md = 0; md < HD / 16; ++md) o[md][nq] = o[md][nq] * alpha;
#pragma unroll
            for (int t = 0; t < 2; ++t) { u32x4 w;
                w.x = cvt_pk_bf16(st[2 * t][nq][0], st[2 * t][nq][1]); w.y = cvt_pk_bf16(st[2 * t][nq][2], st[2 * t][nq][3]);
                w.z = cvt_pk_bf16(st[2 * t + 1][nq][0], st[2 * t + 1][nq][1]); w.w = cvt_pk_bf16(st[2 * t + 1][nq][2], st[2 * t + 1][nq][3]);
                pb[t][nq] = __builtin_bit_cast(bf16x8, w); }
        }
        if (VTG) {
            bf16x8 va[2][8];
            const bf16_t* vt0 = VT + (size_t)(kb * (HD / 64)) * 4096 + fr * 64 + g * 8;
#pragma unroll
            for (int q = 0; q < 8; ++q) va[0][q] = *(const bf16x8*)(vt0 + (16 * (q >> 1)) * 64 + (q & 1) * 32);
#pragma unroll
            for (int dc = 0; dc < HD / 64; ++dc) {
                if (dc + 1 < HD / 64) {
#pragma unroll
                    for (int q = 0; q < 8; ++q) va[(dc + 1) & 1][q] = *(const bf16x8*)(vt0 + (size_t)(dc + 1) * 4096 + (16 * (q >> 1)) * 64 + (q & 1) * 32);
                }
#pragma unroll
                for (int md = 0; md < 4; ++md)
#pragma unroll
                    for (int t = 0; t < 2; ++t)
#pragma unroll
                        for (int nq = 0; nq < NQ; ++nq) o[4 * dc + md][nq] = __builtin_amdgcn_mfma_f32_16x16x32_bf16(va[dc & 1][2 * md + t], pb[t][nq], o[4 * dc + md][nq], 0, 0, 0);
            }
        }
#pragma unroll
        for (int dc = 0; dc < HD / 64; ++dc) {
            if (VTG) continue;
            const bool kvok = lane < nv;
            const bf16_t* vrow = Vp + (size_t)lane * pt + 64 * dc;
#pragma unroll
            for (int cch = 0; cch < 8; ++cch) {
                u32x4 vv = (u32x4){0u, 0u, 0u, 0u};
                if (HD == 64 && cch < NPRE) vv = vpre[cch]; else if (kvok) vv = *(const u32x4*)(vrow + 8 * cch);
                vt[(8 * cch + 0) * 72 + vpos] = (bf16_t)(vv.x & 0xffffu); vt[(8 * cch + 1) * 72 + vpos] = (bf16_t)(vv.x >> 16);
                vt[(8 * cch + 2) * 72 + vpos] = (bf16_t)(vv.y & 0xffffu); vt[(8 * cch + 3) * 72 + vpos] = (bf16_t)(vv.y >> 16);
                vt[(8 * cch + 4) * 72 + vpos] = (bf16_t)(vv.z & 0xffffu); vt[(8 * cch + 5) * 72 + vpos] = (bf16_t)(vv.z >> 16);
                vt[(8 * cch + 6) * 72 + vpos] = (bf16_t)(vv.w & 0xffffu); vt[(8 * cch + 7) * 72 + vpos] = (bf16_t)(vv.w >> 16);
            }
            LDS_WAIT();
#pragma unroll
            for (int md = 0; md < 4; ++md)
#pragma unroll
                for (int t = 0; t < 2; ++t) { const bf16x8 va = *(const LAS bf16x8*)(wl + (16 * md + fr) * 144 + (t * 4 + g) * 16);
#pragma unroll
                    for (int nq = 0; nq < NQ; ++nq) o[4 * dc + md][nq] = __builtin_amdgcn_mfma_f32_16x16x32_bf16(va, pb[t][nq], o[4 * dc + md][nq], 0, 0, 0); }
            LDS_WAIT();
        }
    }
    __builtin_amdgcn_sched_barrier(0); asm volatile("s_nop 15" ::: "memory"); __builtin_amdgcn_sched_barrier(0);
#pragma unroll
    for (int nq = 0; nq < NQ; ++nq) { const float inv = 1.0f / lrow[nq];
#pragma unroll
        for (int md = 0; md < HD / 16; ++md) { const f32x4 v = o[md][nq] * inv; u32x2 w; w.x = cvt_pk_bf16(v[0], v[1]); w.y = cvt_pk_bf16(v[2], v[3]);
            *(u32x2*)(O + (size_t)(16 * nq + fr) * opitch + 16 * md + 4 * g) = w; } }
}

__device__ __forceinline__ float gelu_tanh(float x) { const float z = 0.7978845608028654f * (x + 0.044715f * x * x * x); const float e = __expf(2.0f * z); return 0.5f * x * (2.0f - 2.0f * __builtin_amdgcn_rcpf(1.0f + e)); }
template <bool FULL>
__device__ __forceinline__ void ssm_run(const Params& p, int gi, size_t row0, int nsub, float& s_re, float& s_im, LAS unsigned char* wl, int lane) {
    const int fr = lane & 15, g = lane >> 4;
    const bf16_t* PROJ = (const bf16_t*)(p.ws + WS_BIG); bf16_t* YS = (bf16_t*)(p.ws + WS_YS);
    const float* SAB = (const float*)(p.ws + WS_SAB); const bf16_t* SBB = (const bf16_t*)(p.ws + WS_SBB); const bf16_t* SCM = (const bf16_t*)(p.ws + WS_SCM);
    const f32x4 ab = *(const f32x4*)(SAB + (size_t)(gi * 64 + lane) * 4);
    const float a_re = ab[0], a_im = ab[1];
    bf16x4 bbf[8];
#pragma unroll
    for (int t = 0; t < 8; ++t) bbf[t] = *(const bf16x4*)(SBB + (size_t)(gi * 128 + 16 * t + fr) * 16 + 4 * g);
    bf16x8 cmf[4]; float dval = 0.f;
    if (FULL) {
#pragma unroll
        for (int kk = 0; kk < 4; ++kk) cmf[kk] = *(const bf16x8*)(SCM + (size_t)(gi * 16 + fr) * 128 + 32 * kk + 8 * g);
        dval = p.in[I_SD][gi * 16 + fr];
    }
    LAS float* BUl = (LAS float*)wl;
    LAS bf16_t* Sl = (LAS bf16_t*)(wl + 8448);
    bf16x4 uf_nx = *(const bf16x4*)(PROJ + (row0 + fr) * NIN5 + gi * 16 + 4 * g);
    for (int sc = 0; sc < nsub; ++sc) {
        const size_t t0 = row0 + 16 * sc;
        const bf16x4 uf = uf_nx;
        if (sc + 1 < nsub) uf_nx = *(const bf16x4*)(PROJ + (t0 + 16 + fr) * NIN5 + gi * 16 + 4 * g);
        bf16_t upre[4];
        if (FULL) {
#pragma unroll
            for (int j = 0; j < 4; ++j) upre[j] = PROJ[(t0 + 4 * g + j) * NIN5 + gi * 16 + fr];
        }
        f32x4 bu[8];
#pragma unroll
        for (int t = 0; t < 8; ++t) bu[t] = __builtin_amdgcn_mfma_f32_16x16x16bf16_1k(bbf[t], uf, (f32x4){0.f, 0.f, 0.f, 0.f}, 0, 0, 0);
        __builtin_amdgcn_sched_barrier(0); asm volatile("s_nop 15\n\ts_nop 15" ::: "memory"); __builtin_amdgcn_sched_barrier(0);
#pragma unroll
        for (int t = 0; t < 8; ++t) *(LAS f32x4*)(BUl + fr * 132 + 16 * t + 4 * g) = bu[t];
        LDS_WAIT();
        float br[16], bi[16];
#pragma unroll
        for (int t = 0; t < 16; ++t) { br[t] = BUl[t * 132 + lane]; bi[t] = BUl[t * 132 + 64 + lane]; }
#pragma unroll
        for (int t = 0; t < 16; ++t) {
            const float nr = fmaf(a_re, s_re, fmaf(-a_im, s_im, br[t])), ni = fmaf(a_re, s_im, fmaf(a_im, s_re, bi[t]));
            s_re = nr; s_im = ni;
            if (FULL) { const unsigned w = cvt_pk_bf16(nr, ni); Sl[t * 136 + lane] = (bf16_t)(w & 0xffffu); Sl[t * 136 + 64 + lane] = (bf16_t)(w >> 16); }
        }
        if (FULL) {
            LDS_WAIT();
            f32x4 y = (f32x4){0.f, 0.f, 0.f, 0.f};
#pragma unroll
            for (int kk = 0; kk < 4; ++kk) { const bf16x8 sf = *(const LAS bf16x8*)(wl + 8448 + (fr * 136 + 32 * kk + 8 * g) * 2);
                y = __builtin_amdgcn_mfma_f32_16x16x32_bf16(sf, cmf[kk], y, 0, 0, 0); }
            __builtin_amdgcn_sched_barrier(0); asm volatile("s_nop 15\n\ts_nop 15" ::: "memory"); __builtin_amdgcn_sched_barrier(0);
#pragma unroll
            for (int j = 0; j < 4; ++j) { const size_t tok = t0 + 4 * g + j; const float uu = bf2f(upre[j]);
                const float yy = gelu_tanh(y[j] + dval * uu); YS[tok * 1024 + gi * 16 + fr] = (bf16_t)(cvt_pk_bf16(yy, 0.f) & 0xffffu); }
        }
        LDS_WAIT();
    }
}

#define XB_TMO      128
#define XB_XCNT(j)  (256  + 64 * (j))
#define XB_XSUB(j)  (1280 + 64 * (j))
#define XB_XGEN(j)  (2304 + 64 * (j))
#define XB_TOP      3328
#define XB_TOPGEN   3392
#define XCD_BAR_WORDS 3456
#define XB_SPIN_CAP (1u << 18)

__device__ __forceinline__ unsigned xb_ld(unsigned* p)              { return __hip_atomic_load(p, __ATOMIC_RELAXED, __HIP_MEMORY_SCOPE_AGENT); }
__device__ __forceinline__ unsigned xb_add(unsigned* p, unsigned v) { return __hip_atomic_fetch_add(p, v, __ATOMIC_RELAXED, __HIP_MEMORY_SCOPE_AGENT); }
__device__ __forceinline__ unsigned xb_xcc_id() { return (unsigned)__builtin_amdgcn_s_getreg((3 << 11) | 20) & 0xFu; }
#define XB_SPIN(cond, bar) do { unsigned _sp = 0; while (cond) { __builtin_amdgcn_s_sleep(1); \
    if ((++_sp & 255u) == 0u) { if (xb_ld(&(bar)[XB_TMO])) break; if (_sp > XB_SPIN_CAP) { atomicAdd(&(bar)[XB_TMO], 1u); break; } } } } while (0)

struct XcdBarrier {
    unsigned* bar; unsigned x;
    volatile LAS unsigned* st;
};

__device__ __forceinline__ XcdBarrier xcd_barrier_post(unsigned* bar, volatile LAS unsigned* st) {
    XcdBarrier b; b.bar = bar; b.x = xb_xcc_id(); b.st = st;
    if (threadIdx.x == 0) (void)xb_add(&bar[XB_XCNT(b.x)], 1u);
    return b;
}
__device__ __forceinline__ void xcd_barrier_complete(unsigned* bar, unsigned x, unsigned& nloc, unsigned& nx) {
    const unsigned G = gridDim.x * gridDim.y * gridDim.z;
    unsigned sum, cnt, mine, sp = 0u;
    for (;;) {
        sum = 0u; cnt = 0u; mine = 0u;
#pragma unroll
        for (unsigned j = 0; j < 16; ++j) { const unsigned c = xb_ld(&bar[XB_XCNT(j)]); sum += c; cnt += (c > 0u) ? 1u : 0u; mine = (j == x) ? c : mine; }
        if (sum == G) break;
        __builtin_amdgcn_s_sleep(1);
        if ((++sp & 255u) == 0u) { if (xb_ld(&bar[XB_TMO])) break; if (sp > XB_SPIN_CAP) { atomicAdd(&bar[XB_TMO], 1u); break; } }
    }
    nloc = mine > 0u ? mine : 1u; nx = cnt > 0u ? cnt : 1u;
}

__device__ __forceinline__ void xcd_barrier(const XcdBarrier& b) {
    asm volatile("s_waitcnt vmcnt(0)" ::: "memory");
    __syncthreads();
    if (threadIdx.x == 0) {
        unsigned* bar = b.bar;
        __builtin_amdgcn_s_waitcnt(0);
        unsigned nloc = b.st[0], nx = b.st[1];
        if (nloc == 0u) { xcd_barrier_complete(bar, b.x, nloc, nx); b.st[0] = nloc; b.st[1] = nx; }
        const unsigned old = xb_add(&bar[XB_XSUB(b.x)], 1u);
        const unsigned gen = old / nloc;
        if (old + 1u == (gen + 1u) * nloc) {
            __builtin_amdgcn_fence(__ATOMIC_RELEASE, "agent");
            asm volatile("s_waitcnt vmcnt(0)" ::: "memory");
            const unsigned og = xb_add(&bar[XB_TOP], 1u);
            const unsigned tg = og / nx;
            if (og + 1u == (tg + 1u) * nx) xb_add(&bar[XB_TOPGEN], 1u);
            else XB_SPIN(xb_ld(&bar[XB_TOPGEN]) == tg, bar);
            __builtin_amdgcn_fence(__ATOMIC_ACQUIRE, "agent");
            xb_add(&bar[XB_XGEN(b.x)], 1u);
            asm volatile("s_waitcnt vmcnt(0)" ::: "memory");
        } else {
            XB_SPIN(xb_ld(&bar[XB_XGEN(b.x)]) == gen, bar);
            __builtin_amdgcn_fence(__ATOMIC_ACQUIRE, "agent");
            asm volatile("s_waitcnt vmcnt(0)" ::: "memory");
        }
    }
    __syncthreads();
}


__global__ void __launch_bounds__(512, 2) mega_fwd(Params p) {
    extern __shared__ __attribute__((aligned(16))) unsigned char lds_raw[];
    cg::grid_group grid = cg::this_grid();
    LAS unsigned char* lds = (LAS unsigned char*)lds_raw;
    const int wave = __builtin_amdgcn_readfirstlane(threadIdx.x >> 6);
    const int G = gridDim.x, gw = blockIdx.x * 8 + wave, NGW = G * 8;
    LAS unsigned char* wl = lds + wave * WLDS;
    unsigned char* ws = p.ws;
    bf16_t* U = (bf16_t*)(ws + WS_U); bf16_t* BIG = (bf16_t*)(ws + WS_BIG); bf16_t* YO = (bf16_t*)(ws + WS_YO); float* RSQ = (float*)(ws + WS_RSQ);
    bf16_t* OS = YO; bf16_t* OA = YO + (size_t)M * 1024; bf16_t* OM = YO + (size_t)2 * M * 1024; bf16_t* YS = (bf16_t*)(ws + WS_YS);
    volatile LAS unsigned* bst = (volatile LAS unsigned*)(lds + 131072 + 64);
    if (threadIdx.x < 2) bst[threadIdx.x] = 0u;
    __syncthreads();
    const XcdBarrier xbar = xcd_barrier_post((unsigned*)ws, bst);
    const int lo = p.ph_lo, hi = p.ph_hi;
#define IN(k) (lo <= (k) && (k) < hi)
#define GSYNC() do { asm volatile("s_waitcnt vmcnt(0) lgkmcnt(0)" ::: "memory"); grid.sync(); __builtin_amdgcn_fence(__ATOMIC_ACQUIRE, "agent"); asm volatile("s_waitcnt vmcnt(0)" ::: "memory"); } while (0)
#define XSYNC() do { xcd_barrier(xbar); } while (0)
#define SEAM(k) do { if (IN(k) && IN((k) + 1)) { if ((k) == 0) GSYNC(); else XSYNC(); } } while (0)

    if (IN(0)) {
        const int lane = lane_id();
        LAS float* scr = (LAS float*)wl;
        struct TJ { int idx, K, N; size_t dst; int roff, inter; };
        const TJ jobs[15] = {
            {I_F1G, D, FF, WS_WGU1, 0, 1}, {I_F1U, D, FF, WS_WGU1, 128, 1}, {I_F1D, FF, D, WS_WD1, 0, 0}, {I_WIN, D, 11264, WS_WIN, 0, 0},
            {I_SWGLU, 1024, 1024, WS_WGLU, 0, 0}, {I_WMK, D, 1024, WS_WMKV, 0, 0}, {I_WMV, D, 1024, WS_WMKV, 1024, 0},
            {I_WBS, 1024, D, WS_WBR, 0, 0}, {I_WBA, 1024, D, WS_WBR + (size_t)2048 * 1024 * 2, 0, 0}, {I_WBM, 1024, D, WS_WBR + (size_t)2 * 2048 * 1024 * 2, 0, 0},
            {I_WOUT, D, D, WS_WOUT, 0, 0}, {I_F2G, D, FF, WS_WGU2, 0, 1}, {I_F2U, D, FF, WS_WGU2, 128, 1}, {I_F2D, FF, D, WS_WD2, 0, 0}, {0, 0, 0, 0, 0, 0}};
        int base = 0;
#pragma unroll
        for (int j = 0; j < 14; ++j) {
            const int K = jobs[j].K, N = jobs[j].N, ni = (K / 64) * (N / 32);
            int first = (gw - (base % NGW)); if (first < 0) first += NGW;
            for (int it = first; it < ni; it += NGW) tr_item(p.in[jobs[j].idx], K, N, (bf16_t*)(ws + jobs[j].dst), jobs[j].roff, jobs[j].inter, scr, it, lane);
            base += ni;
        }
        for (int row = gw; row < M; row += NGW)
            rms_row_to_bf16(row < MP ? p.in[I_XP] + (size_t)row * D : p.in[I_XS] + (size_t)(row - MP) * D, p.in[I_F1PRE], U + (size_t)row * D, lane);
        for (int row = gw; row < 2048; row += NGW) rms_row_to_bf16(p.in[I_MEMP] + (size_t)row * D, p.in[I_MEMNORM], (bf16_t*)(ws + WS_MN) + (size_t)row * D, lane);
        cvt_copy(p.in[I_CAK], (bf16_t*)(ws + WS_CK), (size_t)16 * 512 * 1024, gw, NGW, lane);
        cvt_copy(p.in[I_CAV], (bf16_t*)(ws + WS_CV), (size_t)16 * 512 * 1024, gw, NGW, lane);
        cvt_copy(p.in[I_CMK], (bf16_t*)(ws + WS_CMK), (size_t)16 * 256 * 1024, gw, NGW, lane);
        mvt_build<float>(p.in[I_CMV], 1024, 0, (bf16_t*)(ws + WS_CMVT), 16, (size_t)gw * 64 + lane, (size_t)NGW * 64);
        {
            const int idx = (NGW - 1 - gw) * 64 + lane;
            if (idx < 4096) {
                const int gi = idx >> 6, pp = idx & 63;
                const double are = (double)p.in[I_SARE][idx], aim = (double)p.in[I_SAIM][idx], dt = exp((double)p.in[I_SLDT][gi]);
                const double mag = exp(are * dt), abr = mag * cos(aim * dt), abi = mag * sin(aim * dt);
                const double magL = exp(are * dt * (double)SEG), alr = magL * cos(aim * dt * (double)SEG), ali = magL * sin(aim * dt * (double)SEG);
                const double den = are * are + aim * aim, nr = abr - 1.0, ni = abi;
                const double cr = (nr * are + ni * aim) / den, ci = (ni * are - nr * aim) / den;
                float* SAB = (float*)(ws + WS_SAB); bf16_t* SBB = (bf16_t*)(ws + WS_SBB); bf16_t* SCM = (bf16_t*)(ws + WS_SCM);
                *(f32x4*)(SAB + (size_t)idx * 4) = (f32x4){(float)abr, (float)abi, (float)alr, (float)ali};
#pragma unroll
                for (int h = 0; h < 16; h += 2) {
                    const double br0 = p.in[I_SBRE][(size_t)idx * 16 + h], bi0 = p.in[I_SBIM][(size_t)idx * 16 + h], br1 = p.in[I_SBRE][(size_t)idx * 16 + h + 1], bi1 = p.in[I_SBIM][(size_t)idx * 16 + h + 1];
                    *(unsigned*)(SBB + (size_t)(gi * 128 + pp) * 16 + h) = cvt_pk_bf16((float)(cr * br0 - ci * bi0), (float)(cr * br1 - ci * bi1));
                    *(unsigned*)(SBB + (size_t)(gi * 128 + 64 + pp) * 16 + h) = cvt_pk_bf16((float)(cr * bi0 + ci * br0), (float)(cr * bi1 + ci * br1));
                }
#pragma unroll
                for (int h = 0; h < 16; ++h) {
                    SCM[(size_t)(gi * 16 + h) * 128 + pp] = (bf16_t)(cvt_pk_bf16(p.in[I_SCRE][(size_t)(gi * 16 + h) * 64 + pp], 0.f) & 0xffffu);
                    SCM[(size_t)(gi * 16 + h) * 128 + 64 + pp] = (bf16_t)(cvt_pk_bf16(-p.in[I_SCIM][(size_t)(gi * 16 + h) * 64 + pp], 0.f) & 0xffffu);
                }
            }
        }
    }
    SEAM(0);
    if (IN(1)) {
        { pg8::Gemm g{U, (const bf16_t*)(ws + WS_WGU1), D, 0, 0}; pg8::Sched S; S.init(M, 2 * FF, G, blockIdx.x, 1); pg8::EpiSwiglu E{BIG}; pg8::gemm_phase(lds, g, S, E, wave); }
        { pg8::Gemm g{(const bf16_t*)(ws + WS_MN), (const bf16_t*)(ws + WS_WMKV), D, 0, 0}; pg8::Sched S; S.init(2048, 2048, G, (blockIdx.x + G - 44) % G, 1); pg8::EpiMemKV E{(bf16_t*)(ws + WS_MKV), p.out}; pg8::gemm_phase(lds, g, S, E, wave); }
    }
    SEAM(1);
    if (IN(2)) {
        { pg8::Gemm g{BIG, (const bf16_t*)(ws + WS_WD1), FF, 0, 0}; pg8::Sched S; S.init(MP, D, G, blockIdx.x, 1); pg8::EpiDown E{YO, RSQ}; pg8::gemm_phase(lds, g, S, E, wave); }
        { pg8::Gemm g{BIG + (size_t)MP * FF, (const bf16_t*)(ws + WS_WD1), 512, 1024, 1024, FF}; pg8::SchedSplit S{8, 11, G, (int)blockIdx.x}; pg8::EpiSplitAcc E{(float*)(ws + WS_ZS)}; pg8::gemm_phase(lds, g, S, E, wave); }
    }
    SEAM(2);
    if (IN(3)) { mvt_build<bf16_t>((const bf16_t*)(ws + WS_MKV), 2048, 1024, (bf16_t*)(ws + WS_MVT), 8, (size_t)gw * 64 + lane_id(), (size_t)NGW * 64);
        ew_phase<1>(p, p.in[I_F1POST], p.in[I_MIXPRE], gw, NGW, lane_id(), 11); }
    SEAM(3);
    if (IN(4)) { pg8::Gemm g{U, (const bf16_t*)(ws + WS_WIN), D, 0, 0}; pg8::Sched S; S.init(M, NIN5, G, blockIdx.x, 1); pg8::EpiWin E{BIG, p.out}; pg8::gemm_phase(lds, g, S, E, wave); }
    SEAM(4);
    if (IN(5)) {
        const bf16_t* PROJ = BIG;
        constexpr int N_SA = 8 * 64 * (NSEG - 1), N_BP = 8 * 64 * 16, N_MP = 8 * 256 * 4, N_BS = 256, N_MSs = 64;
        {
            const int lane = lane_id();
            const bool xmap = (G % 8 == 0);
            const int wxs = xmap ? (G / 8) * 8 : NGW, wx0 = xmap ? (int)(blockIdx.x >> 3) * 8 + wave : gw;
            for (int r0 = wx0; r0 < (xmap ? 1024 : N_BP); r0 += wxs) {
                const int r = xmap ? ((int)(blockIdx.x & 7) << 10) + r0 : r0;
                const int h = r & 15, c = (r >> 4) & 63, b = r >> 10;
                const int c0 = c >= 8 ? c - 8 : 0; const size_t qrow = (size_t)b * TP + c * 64, krow = (size_t)b * TP + c0 * 64;
                attn_item<4, 64, true, false>(PROJ + qrow * NIN5 + 1024 + h * 64, NIN5, PROJ + krow * NIN5 + 2048 + h * 64, PROJ + krow * NIN5 + 3072 + h * 64, (size_t)64 * NIN5, NIN5, c - c0 + 1,
                                       nullptr, nullptr, 0, 0, false, c * 64, c0 * 64, 0.125f, p.in[I_RELB] + h * 257, OA + qrow * 1024 + h * 64, 1024, wl, lane);
            }
        }
        {
            const int lane = lane_id();
            for (int r = (gw + NGW - 512) % NGW; r < N_SA; r += NGW) {
                const int gi = r & 63, rest = r >> 6, seg = rest % (NSEG - 1), b = rest / (NSEG - 1), bg = b * 64 + gi;
                float s_re = 0.f, s_im = 0.f;
                ssm_run<false>(p, gi, (size_t)b * TP + seg * SEG, SEG / 16, s_re, s_im, wl, lane);
                float* SE = (float*)(ws + WS_SE) + ((size_t)bg * NSEG + seg) * 128; SE[lane] = s_re; SE[64 + lane] = s_im;
            }
        }
        {
            const int lane = lane_id();
            const bool xmap = (G % 8 == 0);
            const int wxs = xmap ? (G / 8) * 8 : NGW, wx0 = xmap ? (int)(blockIdx.x >> 3) * 8 + wave : gw;
            for (int r0 = wx0; r0 < (xmap ? 1024 : N_MP); r0 += wxs) {
                const int r = xmap ? ((int)(blockIdx.x & 7) << 10) + r0 : r0;
                const int h = r & 3, qb = (r >> 2) & 255, b = r >> 10;
                const size_t qrow = (size_t)b * TP + qb * 16; const bf16_t* MKV = (const bf16_t*)(ws + WS_MKV) + (size_t)b * 256 * 2048 + h * 256;
                attn_item<1, 256, false, true>(PROJ + qrow * NIN5 + 4096 + h * 256, NIN5, MKV, MKV + 1024, (size_t)64 * 2048, 2048, 4,
                                         nullptr, nullptr, 0, 0, false, 0, 0, 0.0625f, nullptr, OM + qrow * 1024 + h * 256, 1024, wl, lane, (const bf16_t*)(ws + WS_MVT) + (size_t)(b * 4 + h) * 65536);
            }
        }
        {
            const int lane = lane_id();
            for (int r = (gw + NGW - 1536) % NGW; r < N_BS; r += NGW) {
                const int h = r & 15, b = r >> 4; const size_t qrow = (size_t)MP + b * 16;
                const bf16_t* CK = (const bf16_t*)(ws + WS_CK) + (size_t)b * 512 * 1024 + h * 64; const bf16_t* CV = (const bf16_t*)(ws + WS_CV) + (size_t)b * 512 * 1024 + h * 64;
                attn_item<1, 64, true, false>(PROJ + qrow * NIN5 + 1024 + h * 64, NIN5, CK, CV, (size_t)64 * 1024, 1024, 8,
                                       PROJ + qrow * NIN5 + 2048 + h * 64, PROJ + qrow * NIN5 + 3072 + h * 64, NIN5, 16, true, 4096, 3584, 0.125f, p.in[I_RELB] + h * 257,
                                       OA + qrow * 1024 + h * 64, 1024, wl, lane);
            }
        }
        {
            const int lane = lane_id();
            for (int r = (gw + NGW - 1800) % NGW; r < N_MSs; r += NGW) {
                const int h = r & 3, b = r >> 2; const size_t qrow = (size_t)MP + b * 16;
                const bf16_t* CMK = (const bf16_t*)(ws + WS_CMK) + (size_t)b * 256 * 1024 + h * 256; const bf16_t* CMV = (const bf16_t*)(ws + WS_CMV) + (size_t)b * 256 * 1024 + h * 256;
                attn_item<1, 256, false, true>(PROJ + qrow * NIN5 + 4096 + h * 256, NIN5, CMK, CMV, (size_t)64 * 1024, 1024, 4,
                                         nullptr, nullptr, 0, 0, false, 0, 0, 0.0625f, nullptr, OM + qrow * 1024 + h * 256, 1024, wl, lane, (const bf16_t*)(ws + WS_CMVT) + (size_t)(b * 4 + h) * 65536);
            }
        }
    }
    SEAM(5);
    if (IN(6)) {
        const int lane = lane_id();
        constexpr int N_SB = 8 * 64 * NSEG, N_SS = 16 * 64;
        const float* SAB = (const float*)(ws + WS_SAB);
        for (int it = gw; it < N_SB + N_SS; it += NGW) {
            if (it < N_SB) {
                const int gi = it & 63, seg = (it >> 6) & (NSEG - 1), b = it >> 10, bg = b * 64 + gi;
                const f32x4 ab = *(const f32x4*)(SAB + (size_t)(gi * 64 + lane) * 4);
                float s_re = 0.f, s_im = 0.f; const float* SE = (const float*)(ws + WS_SE) + (size_t)bg * NSEG * 128;
                for (int i = 0; i < seg; ++i) { const float er = SE[i * 128 + lane], ei = SE[i * 128 + 64 + lane];
                    const float nr = fmaf(ab[2], s_re, fmaf(-ab[3], s_im, er)), ni = fmaf(ab[2], s_im, fmaf(ab[3], s_re, ei)); s_re = nr; s_im = ni; }
                ssm_run<true>(p, gi, (size_t)b * TP + seg * SEG, SEG / 16, s_re, s_im, wl, lane);
                if (seg == NSEG - 1) { p.out[O_SRE_P + (size_t)bg * 64 + lane] = s_re; p.out[O_SIM_P + (size_t)bg * 64 + lane] = s_im; }
            } else {
                const int bg = it - N_SB, gi = bg & 63, b = bg >> 6;
                float s_re = p.in[I_SRE][(size_t)bg * 64 + lane], s_im = p.in[I_SIM][(size_t)bg * 64 + lane];
                ssm_run<true>(p, gi, (size_t)MP + b * 16, 1, s_re, s_im, wl, lane);
                p.out[O_SRE_S + (size_t)bg * 64 + lane] = s_re; p.out[O_SIM_S + (size_t)bg * 64 + lane] = s_im;
            }
        }
    }
    SEAM(6);
    if (IN(7)) {
        { pg8::Gemm g{YS, (const bf16_t*)(ws + WS_WGLU), 1024, 0, 0}; pg8::Sched S; S.init(M, 1024, G, blockIdx.x, 1); pg8::EpiGlu E{YS, p.in[I_SBGLU], OS}; pg8::gemm_phase(lds, g, S, E, wave); }
        { pg8::Gemm g{U, (const bf16_t*)(ws + WS_WIN) + (size_t)NIN5 * D, D, 0, 0}; pg8::Sched S; S.init(M, NGATE, G, (blockIdx.x + G - 4) % G, 1); pg8::EpiGate E{BIG};
        pg8::gemm_phase(lds, g, S, E, wave); }
    }
    SEAM(7);
    if (IN(8)) {
        pg8::Gemm g{OS, (const bf16_t*)(ws + WS_WBR), 1024, (size_t)M * 1024 * 2, (size_t)2048 * 1024 * 2}; pg8::Sched S; S.init(M, D, G, blockIdx.x, 3); pg8::EpiBranch E{BIG, U}; pg8::gemm_phase(lds, g, S, E, wave); }
    SEAM(8);
    if (IN(9)) {
        { pg8::Gemm g{U, (const bf16_t*)(ws + WS_WOUT), D, 0, 0}; pg8::Sched S; S.init(MP, D, G, blockIdx.x, 1); pg8::EpiDown E{YO, RSQ}; pg8::gemm_phase(lds, g, S, E, wave); }
        { pg8::Gemm g{U + (size_t)MP * D, (const bf16_t*)(ws + WS_WOUT), 512, 1024, 1024, D}; pg8::SchedSplit S{8, 4, G, (int)blockIdx.x}; pg8::EpiSplitAcc E{(float*)(ws + WS_ZS)}; pg8::gemm_phase(lds, g, S, E, wave); }
    }
    SEAM(9);
    if (IN(10)) ew_phase<2>(p, p.in[I_MIXPOST], p.in[I_F2PRE], gw, NGW, lane_id(), 4);
    SEAM(10);
    if (IN(11)) {
        pg8::Gemm g{U, (const bf16_t*)(ws + WS_WGU2), D, 0, 0}; pg8::Sched S; S.init(M, 2 * FF, G, blockIdx.x, 1); pg8::EpiSwiglu E{BIG}; pg8::gemm_phase(lds, g, S, E, wave); }
    SEAM(11);
    if (IN(12)) {
        { pg8::Gemm g{BIG, (const bf16_t*)(ws + WS_WD2), FF, 0, 0}; pg8::Sched S; S.init(MP, D, G, blockIdx.x, 1); pg8::EpiDown E{YO, RSQ}; pg8::gemm_phase(lds, g, S, E, wave); }
        { pg8::Gemm g{BIG + (size_t)MP * FF, (const bf16_t*)(ws + WS_WD2), 512, 1024, 1024, FF}; pg8::SchedSplit S{8, 11, G, (int)blockIdx.x}; pg8::EpiSplitAcc E{(float*)(ws + WS_ZS)}; pg8::gemm_phase(lds, g, S, E, wave); }
    }
    SEAM(12);
    if (IN(13)) ew_phase<3>(p, p.in[I_F2POST], nullptr, gw, NGW, lane_id(), 11);
#undef IN
#undef SEAM
}

extern "C" void kernel_launch(void* const* d_in, const int* in_sizes, int n_in, void* d_out, int out_size, void* d_ws, size_t ws_size, hipStream_t stream) {
    static int grid = 0;
    if (grid == 0) {
        if (n_in != 40 || ws_size < WS_END) { fprintf(stderr, "kernel_launch: unexpected n_in %d / ws %zu\n", n_in, ws_size); grid = -1; return; }
        int dev = 0, cus = 0, per_cu = 0;
        hipGetDevice(&dev); hipDeviceGetAttribute(&cus, hipDeviceAttributeMultiprocessorCount, dev);
        if (hipFuncSetAttribute((const void*)mega_fwd, hipFuncAttributeMaxDynamicSharedMemorySize, LDS_BYTES) != hipSuccess) { fprintf(stderr, "kernel_launch: hipFuncSetAttribute failed\n"); grid = -1; return; }
        if (hipOccupancyMaxActiveBlocksPerMultiprocessor(&per_cu, (const void*)mega_fwd, 512, LDS_BYTES) != hipSuccess || per_cu < 1) { fprintf(stderr, "kernel_launch: occupancy query says %d\n", per_cu); per_cu = 1; }
        (void)hipGetLastError();
        grid = cus * per_cu;
    }
    if (grid < 0) return;
    if (hipMemsetAsync(d_ws, 0, 16384, stream) != hipSuccess) { fprintf(stderr, "kernel_launch: memset of barrier words failed\n"); return; }
    Params p{};
    for (int i = 0; i < 40; ++i) p.in[i] = (const float*)d_in[i];
    p.out = (float*)d_out; p.ws = (unsigned char*)d_ws; p.ph_lo = 0; p.ph_hi = 14;
    void* args[] = {&p};
    hipError_t e = hipLaunchCooperativeKernel((const void*)mega_fwd, dim3(grid), dim3(512), args, LDS_BYTES, stream);
    if (e != hipSuccess) fprintf(stderr, "cooperative launch failed: %s (grid %d)\n", hipGetErrorString(e), grid);
}
```

```cpp
#include <hip/hip_runtime.h>
#include <hip/hip_cooperative_groups.h>
#include <cstdio>
#include <cstdint>
namespace cg = cooperative_groups;

#define LAS __attribute__((address_space(3)))
typedef unsigned short bf16_t;
typedef short bf16x8 __attribute__((ext_vector_type(8)));
typedef short bf16x4 __attribute__((ext_vector_type(4)));
typedef float f32x4 __attribute__((ext_vector_type(4)));
typedef unsigned u32x4 __attribute__((ext_vector_type(4)));
typedef unsigned u32x2 __attribute__((ext_vector_type(2)));

constexpr int D = 2048, MP = 32768, MS = 256, M = MP + MS, FF = 5632, NIN5 = 5120, NGATE = 6144, TP = 4096;
constexpr float EPS = 1e-6f;
constexpr int SEG = 256, NSEG = TP / SEG;
constexpr size_t O_Y = 0;
constexpr size_t O_ATTK_P = (size_t)M * D;
constexpr size_t O_ATTV_P = O_ATTK_P + 4194304;
constexpr size_t O_MEMK_P = O_ATTV_P + 4194304;
constexpr size_t O_MEMV_P = O_MEMK_P + 2097152;
constexpr size_t O_SRE_P = O_MEMV_P + 2097152;
constexpr size_t O_SIM_P = O_SRE_P + 32768;
constexpr size_t O_ATTK_S = O_SIM_P + 32768;
constexpr size_t O_ATTV_S = O_ATTK_S + 262144;
constexpr size_t O_SRE_S = O_ATTV_S + 262144;
constexpr size_t O_SIM_S = O_SRE_S + 65536;
constexpr size_t MiB = 1u << 20;
constexpr size_t WS_WGU1 = 1 * MiB, WS_WD1 = 45 * MiB, WS_WIN = 67 * MiB, WS_WGLU = 111 * MiB, WS_WMKV = 113 * MiB, WS_WBR = 121 * MiB,
                 WS_WOUT = 133 * MiB, WS_WGU2 = 141 * MiB, WS_WD2 = 185 * MiB;
constexpr size_t WS_YS = 1 * MiB;
constexpr size_t WS_U = 207 * MiB;
constexpr size_t WS_BIG = 336 * MiB;
constexpr size_t WS_YO = 723 * MiB;
constexpr size_t WS_MN = 917 * MiB, WS_MKV = 925 * MiB, WS_CK = 933 * MiB, WS_CV = 949 * MiB, WS_CMK = 965 * MiB, WS_CMV = 973 * MiB;
constexpr size_t WS_RSQ = 981 * MiB;
constexpr size_t WS_SE = 986 * MiB;
constexpr size_t WS_SAB = 990 * MiB;
constexpr size_t WS_SBB = 990 * MiB + 65536;
constexpr size_t WS_SCM = 990 * MiB + 65536 + 262144;
constexpr size_t WS_MVT = 992 * MiB;
constexpr size_t WS_CMVT = 996 * MiB;
constexpr size_t WS_ZS = 691 * MiB;
constexpr size_t WS_END = 1004 * MiB;
constexpr int LDS_BYTES = 147456;
constexpr int WLDS = 16384;

__device__ __forceinline__ unsigned cvt_pk_bf16(float lo, float hi) { unsigned r; asm volatile("s_nop 1\n\tv_cvt_pk_bf16_f32 %0, %1, %2\n\ts_nop 0" : "=v"(r) : "v"(lo), "v"(hi)); return r; }
__device__ __forceinline__ float bf2f(unsigned b) { return __uint_as_float(b << 16); }
__device__ __forceinline__ float bflo(unsigned w) { return __uint_as_float(w << 16); }
__device__ __forceinline__ float bfhi(unsigned w) { return __uint_as_float(w & 0xffff0000u); }
__device__ __forceinline__ float wave_sum(float v) {
#pragma unroll
    for (int o = 1; o < 64; o <<= 1) v += __shfl_xor(v, o);
    return v;
}
__device__ __forceinline__ float sigmoidf_(float x) { return __builtin_amdgcn_rcpf(1.0f + __expf(-x)); }
#define LDS_WAIT() asm volatile("s_waitcnt lgkmcnt(0)" ::: "memory")
__device__ __forceinline__ int lane_id() { int l; asm volatile("v_mbcnt_lo_u32_b32 %0, -1, 0\n\tv_mbcnt_hi_u32_b32 %0, -1, %0" : "=v"(l)); return l; }

namespace pg8 {
constexpr int BM = 256, BK = 64, HALF = 128, HTB = HALF * BK * 2, STAGE_BYTES = 8 * HTB, NXCD = 8, WGM = 8;
__host__ __device__ __forceinline__ int lds_byte(int r, int c) { const int st = (r >> 4) * 2 + (c >> 5), rr = r & 15, cc = c & 31, ob = rr * 64 + cc * 2; return st * 1024 + (ob ^ (((ob >> 9) & 1) << 5)); }
__host__ __device__ __forceinline__ void stage_rc(int b, int& R, int& C) { const int st = b / 1024, sb = b % 1024, swz = sb ^ (((sb >> 9) & 1) << 5); R = (st >> 1) * 16 + swz / 64; C = (st & 1) * 32 + (swz % 64) / 2; }
__host__ __device__ __forceinline__ int perm32(int rho) { const int n = rho >> 4, i = rho & 15; return 8 * (i >> 2) + 4 * n + (i & 3); }

struct Unit { int pm, pn, z; };
struct Gemm { const bf16_t* A; const bf16_t* Bt; int K; size_t zsA, zsB; int ld; };

struct Sched {
    int nM, nN, nwg, G, c, Z;
    __device__ void init(int M_, int N_, int G_, int c_, int Z_) { nM = M_ / BM; nN = N_ / BM; nwg = nM * nN; G = G_; c = c_; Z = Z_; }
    __device__ bool next(int i, Unit& u) const {
        int z = 0, ii = i;
        if (Z > 1) { z = i % Z; ii = i / Z; }
        const long L = (long)ii * G + c; if (L >= nwg) return false;
        int wgid = (int)L; { const int q = nwg / NXCD, r = nwg % NXCD, xcd = wgid % NXCD, off = wgid / NXCD; wgid = (xcd < r ? xcd * (q + 1) : r * (q + 1) + (xcd - r) * q) + off; }
        const int nig = WGM * nN, gid = wgid / nig, fm = gid * WGM, gsz = (nM - fm) < WGM ? (nM - fm) : WGM;
        u.pm = fm + ((wgid % nig) % gsz); u.pn = (wgid % nig) / gsz; u.z = z; return true;
    }
};

template <class Epi, class SchedT>
__device__ __forceinline__ void gemm_phase(LAS unsigned char* lds, const Gemm g, const SchedT& S, const Epi& E, const int wid) {
    const int lane = lane_id(), tid = wid * 64 + lane, wr = wid >> 2, wc = wid & 3, fr = lane & 15, fq = lane >> 4;
    const int K = g.K, nt = K / BK, ld = g.ld ? g.ld : g.K;
    unsigned voffA[2], voffB[2];
#pragma unroll
    for (int i = 0; i < 2; ++i) { int R, C; stage_rc(tid * 16 + i * 8192, R, C); const int Rb = (R & ~31) + perm32(R & 31);
        voffA[i] = (unsigned)(R * ld + C) * 2u; voffB[i] = (unsigned)(Rb * ld + C) * 2u; }
    const size_t kstep = (size_t)(BK * 2);
    const size_t hstep = (size_t)HALF * ld * 2;
    const size_t tstep = 2 * hstep;
    const unsigned ldsw = (unsigned)wid * 1024u;
    const int aoff = lds_byte(wr * 64 + fr, fq * 8), boff = lds_byte(wc * 32 + fr, fq * 8);
#define PG8_SA(b, h) (((b) * 2 + (h)) * HTB)
#define PG8_SB(b, h) ((4 + (b) * 2 + (h)) * HTB)
#define PG8_STAGE(bufoff, gbase, voff) do { _Pragma("unroll") for (int _i = 0; _i < 2; ++_i) \
        __builtin_amdgcn_global_load_lds((const unsigned*)((const char*)(gbase) + (voff)[_i]), (LAS unsigned*)(lds + (bufoff) + ldsw + _i * 8192), 16, 0, 0); } while (0)
#define PG8_LDA(dst, b, h) do { _Pragma("unroll") for (int m = 0; m < 4; ++m) _Pragma("unroll") for (int k = 0; k < 2; ++k) dst[m][k] = *(const LAS bf16x8*)(lds + PG8_SA(b, h) + aoff + m * 2048 + k * 1024); } while (0)
#define PG8_LDB(dst, b, h) do { _Pragma("unroll") for (int n = 0; n < 2; ++n) _Pragma("unroll") for (int k = 0; k < 2; ++k) dst[n][k] = *(const LAS bf16x8*)(lds + PG8_SB(b, h) + boff + n * 2048 + k * 1024); } while (0)
#define PG8_MMA(ai, bj, At, Bt) do { __builtin_amdgcn_s_setprio(1); _Pragma("unroll") for (int m = 0; m < 4; ++m) _Pragma("unroll") for (int n = 0; n < 2; ++n) _Pragma("unroll") for (int k = 0; k < 2; ++k) \
        acc[ai][bj][m][n] = __builtin_amdgcn_mfma_f32_16x16x32_bf16(Bt[n][k], At[m][k], acc[ai][bj][m][n], 0, 0, 0); __builtin_amdgcn_s_setprio(0); } while (0)
#define PG8_WAIT_V(n) asm volatile("s_waitcnt vmcnt(" #n ")" ::: "memory")
#define PG8_WAIT_L(n) asm volatile("s_waitcnt lgkmcnt(" #n ")" ::: "memory")
#define PG8_BAR __builtin_amdgcn_s_barrier()
#define PG8_SCHED __builtin_amdgcn_sched_barrier(0)
    Unit cur, nxt; int ui = 0;
    if (!S.next(0, cur)) return;
    f32x4 acc[2][2][4][2];
#pragma unroll
    for (int a = 0; a < 2; ++a)
#pragma unroll
        for (int b = 0; b < 2; ++b)
#pragma unroll
            for (int m = 0; m < 4; ++m)
#pragma unroll
                for (int n = 0; n < 2; ++n) acc[a][b][m][n] = (f32x4){0.f, 0.f, 0.f, 0.f};
    bf16x8 At[4][2], B0[2][2], B1[2][2];
    const char* cA = (const char*)g.A + (size_t)cur.z * g.zsA + (size_t)cur.pm * tstep; const char* cB = (const char*)g.Bt + (size_t)cur.z * g.zsB + (size_t)cur.pn * tstep;
    PG8_STAGE(PG8_SB(0, 0), cB, voffB); PG8_STAGE(PG8_SB(0, 1), cB + hstep, voffB); PG8_STAGE(PG8_SA(0, 0), cA, voffA); PG8_STAGE(PG8_SA(0, 1), cA + hstep, voffA);
    if (wr == 1) PG8_BAR;
    PG8_WAIT_V(2); PG8_BAR;
    PG8_STAGE(PG8_SB(1, 0), cB + kstep, voffB); PG8_STAGE(PG8_SA(1, 0), cA + kstep, voffA); PG8_STAGE(PG8_SB(1, 1), cB + hstep + kstep, voffB);
    PG8_WAIT_V(6); PG8_BAR;
    for (;;) {
        const bool has_next = S.next(ui + 1, nxt);
        const char* nA = has_next ? (const char*)g.A + (size_t)nxt.z * g.zsA + (size_t)nxt.pm * tstep : cA; const char* nB = has_next ? (const char*)g.Bt + (size_t)nxt.z * g.zsB + (size_t)nxt.pn * tstep : cB;
        for (int t = 0; t < nt; t += 2) {
            const bool last = (t == nt - 2);
            const char* a1 = cA + (size_t)(t + 1) * kstep;
            const char* a2 = last ? nA : cA + (size_t)(t + 2) * kstep; const char* b2 = last ? nB : cB + (size_t)(t + 2) * kstep;
            const char* a3 = a2 + kstep; const char* b3 = b2 + kstep;
            PG8_LDB(B0, 0, 0); PG8_LDB(B1, 0, 1); PG8_SCHED; PG8_LDA(At, 0, 0); PG8_STAGE(PG8_SA(1, 1), a1 + hstep, voffA);
            PG8_WAIT_V(8); PG8_WAIT_L(0); PG8_BAR; PG8_MMA(0, 0, At, B0); PG8_MMA(0, 1, At, B1); PG8_BAR; PG8_SCHED;
            PG8_LDA(At, 0, 1); PG8_STAGE(PG8_SB(0, 0), b2, voffB); PG8_STAGE(PG8_SB(0, 1), b2 + hstep, voffB); PG8_STAGE(PG8_SA(0, 0), a2, voffA);
            PG8_WAIT_V(8); PG8_WAIT_L(0); PG8_BAR; PG8_MMA(1, 0, At, B0); PG8_MMA(1, 1, At, B1); PG8_BAR; PG8_SCHED;
            PG8_LDB(B0, 1, 0); PG8_LDB(B1, 1, 1); PG8_SCHED; PG8_LDA(At, 1, 0); PG8_STAGE(PG8_SA(0, 1), a2 + hstep, voffA);
            PG8_WAIT_V(8); PG8_WAIT_L(0); PG8_BAR; PG8_MMA(0, 0, At, B0); PG8_MMA(0, 1, At, B1); PG8_BAR; PG8_SCHED;
            PG8_LDA(At, 1, 1); PG8_STAGE(PG8_SB(1, 0), b3, voffB); PG8_STAGE(PG8_SB(1, 1), b3 + hstep, voffB); PG8_STAGE(PG8_SA(1, 0), a3, voffA);
            PG8_WAIT_V(8); PG8_WAIT_L(0); PG8_BAR; PG8_MMA(1, 0, At, B0); PG8_MMA(1, 1, At, B1); PG8_BAR; PG8_SCHED;
        }
        if (wr == 0) PG8_BAR;
        E(acc, cur, wr, wc, fr, fq);
        if (!has_next) break;
#pragma unroll
        for (int a = 0; a < 2; ++a)
#pragma unroll
            for (int b = 0; b < 2; ++b)
#pragma unroll
                for (int m = 0; m < 4; ++m)
#pragma unroll
                    for (int n = 0; n < 2; ++n) acc[a][b][m][n] = (f32x4){0.f, 0.f, 0.f, 0.f};
        cur = nxt; cA = nA; cB = nB; ++ui;
        if (wr == 1) PG8_BAR;
    }
    PG8_WAIT_V(0);
    PG8_BAR;
#undef PG8_SA
#undef PG8_SB
#undef PG8_STAGE
#undef PG8_LDA
#undef PG8_LDB
#undef PG8_MMA
#undef PG8_WAIT_V
#undef PG8_WAIT_L
#undef PG8_BAR
#undef PG8_SCHED
}

struct SchedSplit {
    int nN, S, G, c;
    __device__ bool next(int i, Unit& u) const { const int L = i * G + c; if (L >= nN * S) return false; u.pm = 0; u.pn = L % nN; u.z = L / nN; return true; }
};
typedef const f32x4 (&AccRef)[2][2][4][2];
__device__ __forceinline__ u32x4 pack8(const f32x4 a, const f32x4 b) { u32x4 w; w.x = cvt_pk_bf16(a[0], a[1]); w.y = cvt_pk_bf16(a[2], a[3]); w.z = cvt_pk_bf16(b[0], b[1]); w.w = cvt_pk_bf16(b[2], b[3]); return w; }

struct EpiSwiglu {
    bf16_t* ACT;
    __device__ __forceinline__ void operator()(AccRef acc, const Unit& u, int wr, int wc, int fr, int fq) const {
        const int row0 = u.pm * BM + wr * 64 + fr, col = u.pn * 128 + wc * 32 + 8 * fq;
#pragma unroll
        for (int ai = 0; ai < 2; ++ai)
#pragma unroll
            for (int m = 0; m < 4; ++m) {
                f32x4 r0, r1;
#pragma unroll
                for (int j = 0; j < 4; ++j) { const float g0 = acc[ai][0][m][0][j], g1 = acc[ai][0][m][1][j];
                    r0[j] = g0 * sigmoidf_(g0) * acc[ai][1][m][0][j]; r1[j] = g1 * sigmoidf_(g1) * acc[ai][1][m][1][j]; }
                *(u32x4*)(ACT + (size_t)(row0 + ai * HALF + m * 16) * FF + col) = pack8(r0, r1);
            }
    }
};
struct EpiDown {
    bf16_t* Y; float* RSQ;
    __device__ __forceinline__ void operator()(AccRef acc, const Unit& u, int wr, int wc, int fr, int fq) const {
        const int row0 = u.pm * BM + wr * 64 + fr, col = u.pn * BM + wc * 32 + 8 * fq;
#pragma unroll
        for (int ai = 0; ai < 2; ++ai)
#pragma unroll
            for (int m = 0; m < 4; ++m) { const int row = row0 + ai * HALF + m * 16; float s = 0.f;
#pragma unroll
                for (int bj = 0; bj < 2; ++bj) { const f32x4 a = acc[ai][bj][m][0], b = acc[ai][bj][m][1];
                    s += (a[0] * a[0] + a[1] * a[1]) + (a[2] * a[2] + a[3] * a[3]) + (b[0] * b[0] + b[1] * b[1]) + (b[2] * b[2] + b[3] * b[3]);
                    *(u32x4*)(Y + (size_t)row * D + col + bj * HALF) = pack8(a, b); }
                s += __shfl_xor(s, 16); s += __shfl_xor(s, 32);
                if (fq == 0) RSQ[(size_t)row * 32 + u.pn * 4 + wc] = s; }
    }
};
struct EpiSplitAcc {
    float* ZS;
    __device__ __forceinline__ void operator()(AccRef acc, const Unit& u, int wr, int wc, int fr, int fq) const {
        const int row0 = wr * 64 + fr, col = u.pn * BM + wc * 32 + 8 * fq;
#pragma unroll
        for (int ai = 0; ai < 2; ++ai)
#pragma unroll
            for (int m = 0; m < 4; ++m) { float* rp = ZS + (size_t)(row0 + ai * HALF + m * 16) * D + col;
#pragma unroll
                for (int bj = 0; bj < 2; ++bj)
#pragma unroll
                    for (int n = 0; n < 2; ++n) *(f32x4*)(rp + (size_t)u.z * 256 * D + bj * HALF + 4 * n) = acc[ai][bj][m][n]; }
    }
};
struct EpiWin {
    bf16_t* PROJ; float* out;
    __device__ __forceinline__ void operator()(AccRef acc, const Unit& u, int wr, int wc, int fr, int fq) const {
        const int row0 = u.pm * BM + wr * 64 + fr, col = u.pn * BM + wc * 32 + 8 * fq;
        const bool kv = (u.pn >= 8 && u.pn < 16), isk = u.pn < 12, samp = (u.pm == 128), tailp = (!samp && (u.pm & 15) >= 14);
        const int kcol0 = col - (isk ? 2048 : 3072);
#pragma unroll
        for (int ai = 0; ai < 2; ++ai)
#pragma unroll
            for (int m = 0; m < 4; ++m) { const int row = row0 + ai * HALF + m * 16;
#pragma unroll
                for (int bj = 0; bj < 2; ++bj) { const f32x4 a = acc[ai][bj][m][0], b = acc[ai][bj][m][1];
                    *(u32x4*)(PROJ + (size_t)row * NIN5 + col + bj * HALF) = pack8(a, b);
                    if (kv && (samp || tailp)) {
                        float* dst;
                        if (samp) dst = out + (isk ? O_ATTK_S : O_ATTV_S) + (size_t)(row - MP) * 1024 + kcol0 + bj * HALF;
                        else { const int bb = row >> 12, t = row & 4095; dst = out + (isk ? O_ATTK_P : O_ATTV_P) + (size_t)(bb * 512 + t - 3584) * 1024 + kcol0 + bj * HALF; }
                        *(f32x4*)dst = a; *(f32x4*)(dst + 4) = b; } } }
    }
};
struct EpiMemKV {
    bf16_t* MKV; float* out;
    __device__ __forceinline__ void operator()(AccRef acc, const Unit& u, int wr, int wc, int fr, int fq) const {
        const int row0 = u.pm * BM + wr * 64 + fr, col = u.pn * BM + wc * 32 + 8 * fq;
        const bool isk = u.pn < 4; float* ob = out + (isk ? O_MEMK_P : O_MEMV_P) + (col - (isk ? 0 : 1024));
#pragma unroll
        for (int ai = 0; ai < 2; ++ai)
#pragma unroll
            for (int m = 0; m < 4; ++m) { const int row = row0 + ai * HALF + m * 16;
#pragma unroll
                for (int bj = 0; bj < 2; ++bj) { const f32x4 a = acc[ai][bj][m][0], b = acc[ai][bj][m][1];
                    *(u32x4*)(MKV + (size_t)row * 2048 + col + bj * HALF) = pack8(a, b);
                    float* dst = ob + (size_t)row * 1024 + bj * HALF; *(f32x4*)dst = a; *(f32x4*)(dst + 4) = b; } }
    }
};
struct EpiGate {
    bf16_t* G;
    __device__ __forceinline__ void operator()(AccRef acc, const Unit& u, int wr, int wc, int fr, int fq) const {
        const int row0 = u.pm * BM + wr * 64 + fr, col = u.pn * BM + wc * 32 + 8 * fq;
#pragma unroll
        for (int ai = 0; ai < 2; ++ai)
#pragma unroll
            for (int m = 0; m < 4; ++m) { const int row = row0 + ai * HALF + m * 16;
#pragma unroll
                for (int bj = 0; bj < 2; ++bj) { const f32x4 a = acc[ai][bj][m][0], b = acc[ai][bj][m][1];
                    *(u32x4*)(G + (size_t)row * NGATE + col + bj * HALF) = pack8(a, b); } }
    }
};
__device__ __forceinline__ void unpack8(const u32x4 w, f32x4& a, f32x4& b) { a[0] = bflo(w.x); a[1] = bfhi(w.x); a[2] = bflo(w.y); a[3] = bfhi(w.y); b[0] = bflo(w.z); b[1] = bfhi(w.z); b[2] = bflo(w.w); b[3] = bfhi(w.w); }
struct EpiGlu {
    const bf16_t* YS; const float* bias; bf16_t* OS;
    __device__ __forceinline__ void operator()(AccRef acc, const Unit& u, int wr, int wc, int fr, int fq) const {
        const int row0 = u.pm * BM + wr * 64 + fr, col = u.pn * BM + wc * 32 + 8 * fq;
#pragma unroll
        for (int ai = 0; ai < 2; ++ai)
#pragma unroll
            for (int m = 0; m < 4; ++m) { const int row = row0 + ai * HALF + m * 16;
#pragma unroll
                for (int bj = 0; bj < 2; ++bj) { f32x4 a = acc[ai][bj][m][0], b = acc[ai][bj][m][1];
                    const size_t off = (size_t)row * 1024 + col + bj * HALF;
                    const f32x4 b0 = *(const f32x4*)(bias + col + bj * HALF), b1 = *(const f32x4*)(bias + col + bj * HALF + 4);
                    f32x4 y0, y1; unpack8(*(const volatile u32x4*)(YS + off), y0, y1);
#pragma unroll
                    for (int j = 0; j < 4; ++j) { a[j] = y0[j] * sigmoidf_(a[j] + b0[j]); b[j] = y1[j] * sigmoidf_(b[j] + b1[j]); }
                    *(u32x4*)(OS + off) = pack8(a, b); } }
    }
};
struct EpiBranch {
    const bf16_t* G; bf16_t* MG;
    __device__ __forceinline__ void operator()(AccRef acc, const Unit& u, int wr, int wc, int fr, int fq) const {
        const int row0 = u.pm * BM + wr * 64 + fr, col = u.pn * BM + wc * 32 + 8 * fq;
#pragma unroll
        for (int ai = 0; ai < 2; ++ai)
#pragma unroll
            for (int m = 0; m < 4; ++m) { const int row = row0 + ai * HALF + m * 16;
#pragma unroll
                for (int bj = 0; bj < 2; ++bj) { f32x4 a = acc[ai][bj][m][0], b = acc[ai][bj][m][1];
                    f32x4 g0, g1; unpack8(*(const volatile u32x4*)(G + (size_t)row * NGATE + u.z * 2048 + col + bj * HALF), g0, g1);
                    bf16_t* mp = MG + (size_t)row * D + col + bj * HALF;
#pragma unroll
                    for (int j = 0; j < 4; ++j) { a[j] = a[j] * sigmoidf_(g0[j]); b[j] = b[j] * sigmoidf_(g1[j]); }
                    if (u.z > 0) { f32x4 o0, o1; unpack8(*(const volatile u32x4*)mp, o0, o1); a = a + o0; b = b + o1; }
                    *(volatile u32x4*)mp = pack8(a, b); } }
    }
};
}

struct Params { const float* in[40]; float* out; unsigned char* ws; int ph_lo, ph_hi; };
enum { I_XP = 0, I_XS, I_MEMP, I_CAK, I_CAV, I_CMK, I_CMV, I_SRE, I_SIM, I_F1PRE, I_F1POST, I_F1G, I_F1U, I_F1D, I_MIXPRE, I_MIXPOST, I_WIN,
       I_SARE, I_SAIM, I_SLDT, I_SBRE, I_SBIM, I_SCRE, I_SCIM, I_SD, I_SWGLU, I_SBGLU, I_RELB, I_MEMNORM, I_WMK, I_WMV, I_WBS, I_WBA, I_WBM, I_WOUT,
       I_F2PRE, I_F2POST, I_F2G, I_F2U, I_F2D };

__device__ __forceinline__ void tr_item(const float* W, int K, int N, bf16_t* WT, int row_off, int inter, LAS float* scr, int item, int lane) {
    const int nblk = N / 32, kb = item / nblk, nb = item % nblk, k0 = 64 * kb, n0 = 32 * nb;
#pragma unroll 8
    for (int i = 0; i < 32; ++i) { const int kk = 2 * i + (lane >> 5); scr[kk * 33 + (lane & 31)] = __builtin_nontemporal_load(W + (size_t)(k0 + kk) * N + n0 + (lane & 31)); }
    LDS_WAIT();
    const int c = lane & 7;
#pragma unroll
    for (int j = 0; j < 4; ++j) { const int n = (lane >> 3) + 8 * j; const LAS float* s = scr + (8 * c) * 33 + n;
        u32x4 o; o.x = cvt_pk_bf16(s[0 * 33], s[1 * 33]); o.y = cvt_pk_bf16(s[2 * 33], s[3 * 33]); o.z = cvt_pk_bf16(s[4 * 33], s[5 * 33]); o.w = cvt_pk_bf16(s[6 * 33], s[7 * 33]);
        const int col = n0 + n; const int drow = inter ? (((col >> 7) << 8) + (col & 127) + row_off) : (row_off + col);
        *(u32x4*)(WT + (size_t)drow * K + k0 + 8 * c) = o; }
    LDS_WAIT();
}
__device__ __forceinline__ void rms_row_to_bf16(const float* xrow, const float* gain, bf16_t* orow, int lane) {
    f32x4 v[8]; float s = 0.f;
#pragma unroll
    for (int j = 0; j < 8; ++j) { v[j] = __builtin_nontemporal_load((const f32x4*)(xrow + 4 * lane + 256 * j)); s += (v[j][0] * v[j][0] + v[j][1] * v[j][1]) + (v[j][2] * v[j][2] + v[j][3] * v[j][3]); }
    const float rs = rsqrtf(wave_sum(s) * (1.0f / D) + EPS);
#pragma unroll
    for (int j = 0; j < 8; ++j) { const f32x4 gg = *(const f32x4*)(gain + 4 * lane + 256 * j);
        u32x2 w; w.x = cvt_pk_bf16(v[j][0] * rs * gg[0], v[j][1] * rs * gg[1]); w.y = cvt_pk_bf16(v[j][2] * rs * gg[2], v[j][3] * rs * gg[3]);
        *(u32x2*)(orow + 4 * lane + 256 * j) = w; }
}
__device__ __forceinline__ void cvt_copy(const float* src, bf16_t* dst, size_t n, int gw, int NGW, int lane) {
    for (size_t i = ((size_t)gw * 64 + lane) * 8; i < n; i += (size_t)NGW * 512) {
        const f32x4 a = __builtin_nontemporal_load((const f32x4*)(src + i)), b = __builtin_nontemporal_load((const f32x4*)(src + i + 4));
        *(u32x4*)(dst + i) = pg8::pack8(a, b); }
}


__device__ __forceinline__ int vpos_of(int key) { return (key >> 5) * 32 + ((key >> 2) & 3) * 8 + ((key >> 4) & 1) * 4 + (key & 3); }
template <class T> __device__ __forceinline__ void mvt_build(const T* src, int spitch, int scol0, bf16_t* dst, int nb, size_t gtid, size_t nthr) {
    for (size_t idx = gtid; idx < (size_t)nb * 4096; idx += nthr) {
        const int d = (int)(idx & 63), dc = (int)((idx >> 6) & 3), kb = (int)((idx >> 8) & 3), h = (int)((idx >> 10) & 3), b = (int)(idx >> 12);
        const T* sp = src + ((size_t)b * 256 + kb * 64) * spitch + scol0 + h * 256 + dc * 64 + d;
        bf16_t* dp = dst + ((((size_t)(b * 4 + h) * 4 + kb) * 4 + dc) * 64 + d) * 64;
#pragma unroll
        for (int c = 0; c < 8; ++c) { const int t = c >> 2, g = c & 3; float v[8];
#pragma unroll
            for (int i = 0; i < 8; ++i) { const int key = 32 * t + 16 * (i >> 2) + 4 * g + (i & 3);
                if constexpr (sizeof(T) == 4) v[i] = (float)sp[(size_t)key * spitch]; else v[i] = bf2f(sp[(size_t)key * spitch]); }
            u32x4 w; w.x = cvt_pk_bf16(v[0], v[1]); w.y = cvt_pk_bf16(v[2], v[3]); w.z = cvt_pk_bf16(v[4], v[5]); w.w = cvt_pk_bf16(v[6], v[7]);
            *(u32x4*)(dp + 8 * c) = w; }
    }
}

template <int MODE>
__device__ __forceinline__ void ew_phase(const Params& p, const float* gpost, const float* gpre, int gw, int NGW, int lane, int nsplit) {
    float* H = p.out; const bf16_t* Y = (const bf16_t*)(p.ws + WS_YO); const float* RSQ = (const float*)(p.ws + WS_RSQ); bf16_t* U = (bf16_t*)(p.ws + WS_U);
    const float c = (MODE == 2) ? 1.0f : 0.5f;
    for (int row = gw; row < M; row += NGW) {
        const float* hin = (MODE == 1) ? (row < MP ? p.in[I_XP] + (size_t)row * D : p.in[I_XS] + (size_t)(row - MP) * D) : H + (size_t)row * D;
        f32x4 yv[8]; float part = 0.f;
        if (row < MP) {
            part = lane < 32 ? *(const volatile float*)(RSQ + (size_t)row * 32 + lane) : 0.f;
#pragma unroll
            for (int j = 0; j < 8; ++j) { const u32x2 yw = *(const volatile u32x2*)(Y + (size_t)row * D + 4 * lane + 256 * j); yv[j] = (f32x4){bflo(yw.x), bfhi(yw.x), bflo(yw.y), bfhi(yw.y)}; }
        } else {
            const float* zr = (const float*)(p.ws + WS_ZS) + (size_t)(row - MP) * D;
#pragma unroll
            for (int j = 0; j < 8; ++j) { f32x4 a = (f32x4){0.f, 0.f, 0.f, 0.f};
                for (int sl = 0; sl < nsplit; ++sl) { const u32x4 t = *(const volatile u32x4*)(zr + (size_t)sl * 256 * D + 4 * lane + 256 * j); a[0] += __uint_as_float(t.x); a[1] += __uint_as_float(t.y); a[2] += __uint_as_float(t.z); a[3] += __uint_as_float(t.w); }
                yv[j] = a; part += (a[0] * a[0] + a[1] * a[1]) + (a[2] * a[2] + a[3] * a[3]); }
        }
        const float rs = rsqrtf(wave_sum(part) * (1.0f / D) + EPS) * c;
        f32x4 hv[8]; float ss = 0.f;
#pragma unroll
        for (int j = 0; j < 8; ++j) { const int col = 4 * lane + 256 * j;
            const f32x4 h4 = __builtin_nontemporal_load((const f32x4*)(hin + col)); const f32x4 g4 = *(const f32x4*)(gpost + col);
            f32x4 hn; hn[0] = h4[0] + yv[j][0] * rs * g4[0]; hn[1] = h4[1] + yv[j][1] * rs * g4[1]; hn[2] = h4[2] + yv[j][2] * rs * g4[2]; hn[3] = h4[3] + yv[j][3] * rs * g4[3];
            hv[j] = hn; ss += (hn[0] * hn[0] + hn[1] * hn[1]) + (hn[2] * hn[2] + hn[3] * hn[3]);
            __builtin_nontemporal_store(hn, (f32x4*)(H + (size_t)row * D + col)); }
        if (MODE != 3) {
            const float rs2 = rsqrtf(wave_sum(ss) * (1.0f / D) + EPS);
#pragma unroll
            for (int j = 0; j < 8; ++j) { const int col = 4 * lane + 256 * j; const f32x4 gg = *(const f32x4*)(gpre + col);
                u32x2 w; w.x = cvt_pk_bf16(hv[j][0] * rs2 * gg[0], hv[j][1] * rs2 * gg[1]); w.y = cvt_pk_bf16(hv[j][2] * rs2 * gg[2], hv[j][3] * rs2 * gg[3]);
                *(u32x2*)(U + (size_t)row * D + col) = w; }
        }
    }
}

template <int NQ, int HD, bool BIAS, bool VTG>
__device__ __forceinline__ void attn_item(const bf16_t* Q, int qpitch, const bf16_t* K0, const bf16_t* V0, size_t kbstride, int pitch, int nreg,
                                          const bf16_t* Ks, const bf16_t* Vs, int pitch_s, int nvalid_s, bool has_s,
                                          int qpos0, int kpos_base, float scale, const float* bias_g, bf16_t* O, int opitch, LAS unsigned char* wl, int lane, const bf16_t* VT = nullptr) {
    const int fr = lane & 15, g = lane >> 4;
    LAS float* bl = (LAS float*)(wl + 9216);
    LAS bf16_t* vt = (LAS bf16_t*)wl;
    if (BIAS) { for (int i = lane; i < 257; i += 64) bl[i] = bias_g[i]; }
    bf16x8 qf[NQ][HD / 32];
#pragma unroll
    for (int nq = 0; nq < NQ; ++nq)
#pragma unroll
        for (int kd = 0; kd < HD / 32; ++kd) qf[nq][kd] = *(const bf16x8*)(Q + (size_t)(16 * nq + fr) * qpitch + 32 * kd + 8 * g);
    float mrow[NQ], lrow[NQ]; f32x4 o[HD / 16][NQ];
#pragma unroll
    for (int nq = 0; nq < NQ; ++nq) { mrow[nq] = -1e30f; lrow[nq] = 0.f;
#pragma unroll
        for (int md = 0; md < HD / 16; ++md) o[md][nq] = (f32x4){0.f, 0.f, 0.f, 0.f}; }
    LDS_WAIT();
    const int nkb = nreg + (has_s ? 1 : 0);
    const int vpos = (lane >> 5) * 32 + ((lane >> 2) & 3) * 8 + ((lane >> 4) & 1) * 4 + (lane & 3);
    for (int kb = 0; kb < nkb; ++kb) {
        const bool sp = kb >= nreg;
        const bf16_t* Kp = sp ? Ks : K0 + (size_t)kb * kbstride; const bf16_t* Vp = sp ? Vs : V0 + (size_t)kb * kbstride;
        const int pt = sp ? pitch_s : pitch, nv = sp ? nvalid_s : 64;
        f32x4 st[4][NQ];
#pragma unroll
        for (int mk = 0; mk < 4; ++mk) {
#pragma unroll
            for (int nq = 0; nq < NQ; ++nq) st[mk][nq] = (f32x4){0.f, 0.f, 0.f, 0.f};
            const bool kok = (16 * mk + fr) < nv;
#pragma unroll
            for (int kd = 0; kd < HD / 32; ++kd) {
                bf16x8 kf = (bf16x8){0, 0, 0, 0, 0, 0, 0, 0};
                if (kok) kf = *(const bf16x8*)(Kp + (size_t)(16 * mk + fr) * pt + 32 * kd + 8 * g);
#pragma unroll
                for (int nq = 0; nq < NQ; ++nq) st[mk][nq] = __builtin_amdgcn_mfma_f32_16x16x32_bf16(kf, qf[nq][kd], st[mk][nq], 0, 0, 0);
            }
        }
        __builtin_amdgcn_sched_barrier(0); asm volatile("s_nop 15" ::: "memory"); __builtin_amdgcn_sched_barrier(0);
        constexpr int NPRE = (NQ == 4) ? 4 : 8;
        u32x4 vpre[8];
        if (!VTG && HD == 64) { const bool kvok0 = lane < nv; const bf16_t* vrow0 = Vp + (size_t)lane * pt;
#pragma unroll
            for (int cch = 0; cch < NPRE; ++cch) { vpre[cch] = (u32x4){0u, 0u, 0u, 0u}; if (kvok0) vpre[cch] = *(const u32x4*)(vrow0 + 8 * cch); } }
        const bool farb = BIAS && (qpos0 - (kpos_base + 64 * kb + 63) >= 128);
        const float bfar = BIAS ? bl[256] : 0.f;
        bf16x8 pb[2][NQ];
#pragma unroll
        for (int nq = 0; nq < NQ; ++nq) {
            const int qpos = qpos0 + 16 * nq + fr;
            float mx = -1e30f;
#pragma unroll
            for (int mk = 0; mk < 4; ++mk)
#pragma unroll
                for (int j = 0; j < 4; ++j) { const int key = 16 * mk + 4 * g + j; float s = st[mk][nq][j] * scale;
                    if (BIAS) { if (farb) s += bfar; else { int dd = qpos - (kpos_base + 64 * kb + key); dd = dd < -128 ? -128 : (dd > 128 ? 128 : dd); s += bl[dd + 128]; } }
                    if (key >= nv) s = -1e30f;
                    st[mk][nq][j] = s; mx = fmaxf(mx, s); }
            mx = fmaxf(mx, __shfl_xor(mx, 16)); mx = fmaxf(mx, __shfl_xor(mx, 32));
            const float mnew = fmaxf(mrow[nq], mx), alpha = __expf(mrow[nq] - mnew);
            float ps = 0.f;
#pragma unroll
            for (int mk = 0; mk < 4; ++mk)
#pragma unroll
                for (int j = 0; j < 4; ++j) { const float pv = __expf(st[mk][nq][j] - mnew); st[mk][nq][j] = pv; ps += pv; }
            ps += __shfl_xor(ps, 16); ps += __shfl_xor(ps, 32);
            lrow[nq] = lrow[nq] * alpha + ps; mrow[nq] = mnew;
#pragma unroll
            for (int md = 0; md < HD / 16; ++md) o[md][nq] = o[md][nq] * alpha;
#pragma unroll
            for (int t = 0; t < 2; ++t) { u32x4 w;
                w.x = cvt_pk_bf16(st[2 * t][nq][0], st[2 * t][nq][1]); w.y = cvt_pk_bf16(st[2 * t][nq][2], st[2 * t][nq][3]);
                w.z = cvt_pk_bf16(st[2 * t + 1][nq][0], st[2 * t + 1][nq][1]); w.w = cvt_pk_bf16(st[2 * t + 1][nq][2], st[2 * t + 1][nq][3]);
                pb[t][nq] = __builtin_bit_cast(bf16x8, w); }
        }
#pragma unroll
        for (int dc = 0; dc < HD / 64; ++dc) {
            if (VTG) {
                const bf16_t* vtile = VT + (size_t)(kb * (HD / 64) + dc) * 4096;
#pragma unroll
                for (int md = 0; md < 4; ++md)
#pragma unroll
                    for (int t = 0; t < 2; ++t) { const bf16x8 va = *(const bf16x8*)(vtile + (16 * md + fr) * 64 + (t * 4 + g) * 8);
#pragma unroll
                        for (int nq = 0; nq < NQ; ++nq) o[4 * dc + md][nq] = __builtin_amdgcn_mfma_f32_16x16x32_bf16(va, pb[t][nq], o[4 * dc + md][nq], 0, 0, 0); }
                asm volatile("" ::: "memory");
                continue;
            }
            const bool kvok = lane < nv;
            const bf16_t* vrow = Vp + (size_t)lane * pt + 64 * dc;
#pragma unroll
            for (int cch = 0; cch < 8; ++cch) {
                u32x4 vv = (u32x4){0u, 0u, 0u, 0u};
                if (HD == 64 && cch < NPRE) vv = vpre[cch]; else if (kvok) vv = *(const u32x4*)(vrow + 8 * cch);
                vt[(8 * cch + 0) * 72 + vpos] = (bf16_t)(vv.x & 0xffffu); vt[(8 * cch + 1) * 72 + vpos] = (bf16_t)(vv.x >> 16);
                vt[(8 * cch + 2) * 72 + vpos] = (bf16_t)(vv.y & 0xffffu); vt[(8 * cch + 3) * 72 + vpos] = (bf16_t)(vv.y >> 16);
                vt[(8 * cch + 4) * 72 + vpos] = (bf16_t)(vv.z & 0xffffu); vt[(8 * cch + 5) * 72 + vpos] = (bf16_t)(vv.z >> 16);
                vt[(8 * cch + 6) * 72 + vpos] = (bf16_t)(vv.w & 0xffffu); vt[(8 * cch + 7) * 72 + vpos] = (bf16_t)(vv.w >> 16);
            }
            LDS_WAIT();
#pragma unroll
            for (int md = 0; md < 4; ++md)
#pragma unroll
                for (int t = 0; t < 2; ++t) { const bf16x8 va = *(const LAS bf16x8*)(wl + (16 * md + fr) * 144 + (t * 4 + g) * 16);
#pragma unroll
                    for (int nq = 0; nq < NQ; ++nq) o[4 * dc + md][nq] = __builtin_amdgcn_mfma_f32_16x16x32_bf16(va, pb[t][nq], o[4 * dc + md][nq], 0, 0, 0); }
            LDS_WAIT();
        }
    }
    __builtin_amdgcn_sched_barrier(0); asm volatile("s_nop 15" ::: "memory"); __builtin_amdgcn_sched_barrier(0);
#pragma unroll
    for (int nq = 0; nq < NQ; ++nq) { const float inv = 1.0f / lrow[nq];
#pragma unroll
        for (int md = 0; md < HD / 16; ++md) { const f32x4 v = o[md][nq] * inv; u32x2 w; w.x = cvt_pk_bf16(v[0], v[1]); w.y = cvt_pk_bf16(v[2], v[3]);
            *(u32x2*)(O + (size_t)(16 * nq + fr) * opitch + 16 * md + 4 * g) = w; } }
}

__device__ __forceinline__ float gelu_tanh(float x) { const float z = 0.7978845608028654f * (x + 0.044715f * x * x * x); const float e = __expf(2.0f * z); return 0.5f * x * (2.0f - 2.0f * __builtin_amdgcn_rcpf(1.0f + e)); }
template <bool FULL>
__device__ __forceinline__ void ssm_run(const Params& p, int gi, size_t row0, int nsub, float& s_re, float& s_im, LAS unsigned char* wl, int lane) {
    const int fr = lane & 15, g = lane >> 4;
    const bf16_t* PROJ = (const bf16_t*)(p.ws + WS_BIG); bf16_t* YS = (bf16_t*)(p.ws + WS_YS);
    const float* SAB = (const float*)(p.ws + WS_SAB); const bf16_t* SBB = (const bf16_t*)(p.ws + WS_SBB); const bf16_t* SCM = (const bf16_t*)(p.ws + WS_SCM);
    const f32x4 ab = *(const f32x4*)(SAB + (size_t)(gi * 64 + lane) * 4);
    const float a_re = ab[0], a_im = ab[1];
    bf16x4 bbf[8];
#pragma unroll
    for (int t = 0; t < 8; ++t) bbf[t] = *(const bf16x4*)(SBB + (size_t)(gi * 128 + 16 * t + fr) * 16 + 4 * g);
    bf16x8 cmf[4]; float dval = 0.f;
    if (FULL) {
#pragma unroll
        for (int kk = 0; kk < 4; ++kk) cmf[kk] = *(const bf16x8*)(SCM + (size_t)(gi * 16 + fr) * 128 + 32 * kk + 8 * g);
        dval = p.in[I_SD][gi * 16 + fr];
    }
    LAS float* BUl = (LAS float*)wl;
    LAS bf16_t* Sl = (LAS bf16_t*)(wl + 8448);
    bf16x4 uf_nx = *(const bf16x4*)(PROJ + (row0 + fr) * NIN5 + gi * 16 + 4 * g);
    for (int sc = 0; sc < nsub; ++sc) {
        const size_t t0 = row0 + 16 * sc;
        const bf16x4 uf = uf_nx;
        if (sc + 1 < nsub) uf_nx = *(const bf16x4*)(PROJ + (t0 + 16 + fr) * NIN5 + gi * 16 + 4 * g);
        bf16_t upre[4];
        if (FULL) {
#pragma unroll
            for (int j = 0; j < 4; ++j) upre[j] = PROJ[(t0 + 4 * g + j) * NIN5 + gi * 16 + fr];
        }
        f32x4 bu[8];
#pragma unroll
        for (int t = 0; t < 8; ++t) bu[t] = __builtin_amdgcn_mfma_f32_16x16x16bf16_1k(bbf[t], uf, (f32x4){0.f, 0.f, 0.f, 0.f}, 0, 0, 0);
        __builtin_amdgcn_sched_barrier(0); asm volatile("s_nop 15\n\ts_nop 15" ::: "memory"); __builtin_amdgcn_sched_barrier(0);
#pragma unroll
        for (int t = 0; t < 8; ++t) *(LAS f32x4*)(BUl + fr * 132 + 16 * t + 4 * g) = bu[t];
        LDS_WAIT();
        float br[16], bi[16];
#pragma unroll
        for (int t = 0; t < 16; ++t) { br[t] = BUl[t * 132 + lane]; bi[t] = BUl[t * 132 + 64 + lane]; }
#pragma unroll
        for (int t = 0; t < 16; ++t) {
            const float nr = fmaf(a_re, s_re, fmaf(-a_im, s_im, br[t])), ni = fmaf(a_re, s_im, fmaf(a_im, s_re, bi[t]));
            s_re = nr; s_im = ni;
            if (FULL) { const unsigned w = cvt_pk_bf16(nr, ni); Sl[t * 136 + lane] = (bf16_t)(w & 0xffffu); Sl[t * 136 + 64 + lane] = (bf16_t)(w >> 16); }
        }
        if (FULL) {
            LDS_WAIT();
            f32x4 y = (f32x4){0.f, 0.f, 0.f, 0.f};
#pragma unroll
            for (int kk = 0; kk < 4; ++kk) { const bf16x8 sf = *(const LAS bf16x8*)(wl + 8448 + (fr * 136 + 32 * kk + 8 * g) * 2);
                y = __builtin_amdgcn_mfma_f32_16x16x32_bf16(sf, cmf[kk], y, 0, 0, 0); }
            __builtin_amdgcn_sched_barrier(0); asm volatile("s_nop 15\n\ts_nop 15" ::: "memory"); __builtin_amdgcn_sched_barrier(0);
#pragma unroll
            for (int j = 0; j < 4; ++j) { const size_t tok = t0 + 4 * g + j; const float uu = bf2f(upre[j]);
                const float yy = gelu_tanh(y[j] + dval * uu); YS[tok * 1024 + gi * 16 + fr] = (bf16_t)(cvt_pk_bf16(yy, 0.f) & 0xffffu); }
        }
        LDS_WAIT();
    }
}

#define XB_TMO      128
#define XB_XCNT(j)  (256  + 64 * (j))
#define XB_XSUB(j)  (1280 + 64 * (j))
#define XB_XGEN(j)  (2304 + 64 * (j))
#define XB_TOP      3328
#define XB_TOPGEN   3392
#define XCD_BAR_WORDS 3456
#define XB_SPIN_CAP (1u << 18)

__device__ __forceinline__ unsigned xb_ld(unsigned* p)              { return __hip_atomic_load(p, __ATOMIC_RELAXED, __HIP_MEMORY_SCOPE_AGENT); }
__device__ __forceinline__ unsigned xb_add(unsigned* p, unsigned v) { return __hip_atomic_fetch_add(p, v, __ATOMIC_RELAXED, __HIP_MEMORY_SCOPE_AGENT); }
__device__ __forceinline__ unsigned xb_xcc_id() { return (unsigned)__builtin_amdgcn_s_getreg((3 << 11) | 20) & 0xFu; }
#define XB_SPIN(cond, bar) do { unsigned _sp = 0; while (cond) { __builtin_amdgcn_s_sleep(1); \
    if ((++_sp & 255u) == 0u) { if (xb_ld(&(bar)[XB_TMO])) break; if (_sp > XB_SPIN_CAP) { atomicAdd(&(bar)[XB_TMO], 1u); break; } } } } while (0)

struct XcdBarrier {
    unsigned* bar; unsigned x;
    volatile LAS unsigned* st;
};

__device__ __forceinline__ XcdBarrier xcd_barrier_post(unsigned* bar, volatile LAS unsigned* st) {
    XcdBarrier b; b.bar = bar; b.x = xb_xcc_id(); b.st = st;
    if (threadIdx.x == 0) (void)xb_add(&bar[XB_XCNT(b.x)], 1u);
    return b;
}
__device__ __forceinline__ void xcd_barrier_complete(unsigned* bar, unsigned x, unsigned& nloc, unsigned& nx) {
    const unsigned G = gridDim.x * gridDim.y * gridDim.z;
    unsigned sum, cnt, mine, sp = 0u;
    for (;;) {
        sum = 0u; cnt = 0u; mine = 0u;
#pragma unroll
        for (unsigned j = 0; j < 16; ++j) { const unsigned c = xb_ld(&bar[XB_XCNT(j)]); sum += c; cnt += (c > 0u) ? 1u : 0u; mine = (j == x) ? c : mine; }
        if (sum == G) break;
        __builtin_amdgcn_s_sleep(1);
        if ((++sp & 255u) == 0u) { if (xb_ld(&bar[XB_TMO])) break; if (sp > XB_SPIN_CAP) { atomicAdd(&bar[XB_TMO], 1u); break; } }
    }
    nloc = mine > 0u ? mine : 1u; nx = cnt > 0u ? cnt : 1u;
}

__device__ __forceinline__ void xcd_barrier(const XcdBarrier& b) {
    asm volatile("s_waitcnt vmcnt(0)" ::: "memory");
    __syncthreads();
    if (threadIdx.x == 0) {
        unsigned* bar = b.bar;
        __builtin_amdgcn_s_waitcnt(0);
        unsigned nloc = b.st[0], nx = b.st[1];
        if (nloc == 0u) { xcd_barrier_complete(bar, b.x, nloc, nx); b.st[0] = nloc; b.st[1] = nx; }
        const unsigned old = xb_add(&bar[XB_XSUB(b.x)], 1u);
        const unsigned gen = old / nloc;
        if (old + 1u == (gen + 1u) * nloc) {
            __builtin_amdgcn_fence(__ATOMIC_RELEASE, "agent");
            asm volatile("s_waitcnt vmcnt(0)" ::: "memory");
            const unsigned og = xb_add(&bar[XB_TOP], 1u);
            const unsigned tg = og / nx;
            if (og + 1u == (tg + 1u) * nx) xb_add(&bar[XB_TOPGEN], 1u);
            else XB_SPIN(xb_ld(&bar[XB_TOPGEN]) == tg, bar);
            __builtin_amdgcn_fence(__ATOMIC_ACQUIRE, "agent");
            xb_add(&bar[XB_XGEN(b.x)], 1u);
            asm volatile("s_waitcnt vmcnt(0)" ::: "memory");
        } else {
            XB_SPIN(xb_ld(&bar[XB_XGEN(b.x)]) == gen, bar);
            __builtin_amdgcn_fence(__ATOMIC_ACQUIRE, "agent");
            asm volatile("s_waitcnt vmcnt(0)" ::: "memory");
        }
    }
    __syncthreads();
}


__global__ void __launch_bounds__(512, 2) mega_fwd(Params p) {
    extern __shared__ __attribute__((aligned(16))) unsigned char lds_raw[];
    cg::grid_group grid = cg::this_grid();
    LAS unsigned char* lds = (LAS unsigned char*)lds_raw;
    const int wave = __builtin_amdgcn_readfirstlane(threadIdx.x >> 6);
    const int G = gridDim.x, gw = blockIdx.x * 8 + wave, NGW = G * 8;
    LAS unsigned char* wl = lds + wave * WLDS;
    unsigned char* ws = p.ws;
    bf16_t* U = (bf16_t*)(ws + WS_U); bf16_t* BIG = (bf16_t*)(ws + WS_BIG); bf16_t* YO = (bf16_t*)(ws + WS_YO); float* RSQ = (float*)(ws + WS_RSQ);
    bf16_t* OS = YO; bf16_t* OA = YO + (size_t)M * 1024; bf16_t* OM = YO + (size_t)2 * M * 1024; bf16_t* YS = (bf16_t*)(ws + WS_YS);
    volatile LAS unsigned* bst = (volatile LAS unsigned*)(lds + 131072 + 64);
    if (threadIdx.x < 2) bst[threadIdx.x] = 0u;
    __syncthreads();
    const XcdBarrier xbar = xcd_barrier_post((unsigned*)ws, bst);
    const int lo = p.ph_lo, hi = p.ph_hi;
#define IN(k) (lo <= (k) && (k) < hi)
#define GSYNC() do { asm volatile("s_waitcnt vmcnt(0) lgkmcnt(0)" ::: "memory"); grid.sync(); __builtin_amdgcn_fence(__ATOMIC_ACQUIRE, "agent"); asm volatile("s_waitcnt vmcnt(0)" ::: "memory"); } while (0)
#define XSYNC() do { xcd_barrier(xbar); } while (0)
#define SEAM(k) do { if (IN(k) && IN((k) + 1)) { if ((k) == 0) GSYNC(); else XSYNC(); } } while (0)

    if (IN(0)) {
        const int lane = lane_id();
        LAS float* scr = (LAS float*)wl;
        struct TJ { int idx, K, N; size_t dst; int roff, inter; };
        const TJ jobs[15] = {
            {I_F1G, D, FF, WS_WGU1, 0, 1}, {I_F1U, D, FF, WS_WGU1, 128, 1}, {I_F1D, FF, D, WS_WD1, 0, 0}, {I_WIN, D, 11264, WS_WIN, 0, 0},
            {I_SWGLU, 1024, 1024, WS_WGLU, 0, 0}, {I_WMK, D, 1024, WS_WMKV, 0, 0}, {I_WMV, D, 1024, WS_WMKV, 1024, 0},
            {I_WBS, 1024, D, WS_WBR, 0, 0}, {I_WBA, 1024, D, WS_WBR + (size_t)2048 * 1024 * 2, 0, 0}, {I_WBM, 1024, D, WS_WBR + (size_t)2 * 2048 * 1024 * 2, 0, 0},
            {I_WOUT, D, D, WS_WOUT, 0, 0}, {I_F2G, D, FF, WS_WGU2, 0, 1}, {I_F2U, D, FF, WS_WGU2, 128, 1}, {I_F2D, FF, D, WS_WD2, 0, 0}, {0, 0, 0, 0, 0, 0}};
        int base = 0;
#pragma unroll
        for (int j = 0; j < 14; ++j) {
            const int K = jobs[j].K, N = jobs[j].N, ni = (K / 64) * (N / 32);
            int first = (gw - (base % NGW)); if (first < 0) first += NGW;
            for (int it = first; it < ni; it += NGW) tr_item(p.in[jobs[j].idx], K, N, (bf16_t*)(ws + jobs[j].dst), jobs[j].roff, jobs[j].inter, scr, it, lane);
            base += ni;
        }
        for (int row = gw; row < M; row += NGW)
            rms_row_to_bf16(row < MP ? p.in[I_XP] + (size_t)row * D : p.in[I_XS] + (size_t)(row - MP) * D, p.in[I_F1PRE], U + (size_t)row * D, lane);
        for (int row = gw; row < 2048; row += NGW) rms_row_to_bf16(p.in[I_MEMP] + (size_t)row * D, p.in[I_MEMNORM], (bf16_t*)(ws + WS_MN) + (size_t)row * D, lane);
        cvt_copy(p.in[I_CAK], (bf16_t*)(ws + WS_CK), (size_t)16 * 512 * 1024, gw, NGW, lane);
        cvt_copy(p.in[I_CAV], (bf16_t*)(ws + WS_CV), (size_t)16 * 512 * 1024, gw, NGW, lane);
        cvt_copy(p.in[I_CMK], (bf16_t*)(ws + WS_CMK), (size_t)16 * 256 * 1024, gw, NGW, lane);
        mvt_build<float>(p.in[I_CMV], 1024, 0, (bf16_t*)(ws + WS_CMVT), 16, (size_t)gw * 64 + lane, (size_t)NGW * 64);
        {
            const int idx = (NGW - 1 - gw) * 64 + lane;
            if (idx < 4096) {
                const int gi = idx >> 6, pp = idx & 63;
                const double are = (double)p.in[I_SARE][idx], aim = (double)p.in[I_SAIM][idx], dt = exp((double)p.in[I_SLDT][gi]);
                const double mag = exp(are * dt), abr = mag * cos(aim * dt), abi = mag * sin(aim * dt);
                const double magL = exp(are * dt * (double)SEG), alr = magL * cos(aim * dt * (double)SEG), ali = magL * sin(aim * dt * (double)SEG);
                const double den = are * are + aim * aim, nr = abr - 1.0, ni = abi;
                const double cr = (nr * are + ni * aim) / den, ci = (ni * are - nr * aim) / den;
                float* SAB = (float*)(ws + WS_SAB); bf16_t* SBB = (bf16_t*)(ws + WS_SBB); bf16_t* SCM = (bf16_t*)(ws + WS_SCM);
                *(f32x4*)(SAB + (size_t)idx * 4) = (f32x4){(float)abr, (float)abi, (float)alr, (float)ali};
#pragma unroll
                for (int h = 0; h < 16; h += 2) {
                    const double br0 = p.in[I_SBRE][(size_t)idx * 16 + h], bi0 = p.in[I_SBIM][(size_t)idx * 16 + h], br1 = p.in[I_SBRE][(size_t)idx * 16 + h + 1], bi1 = p.in[I_SBIM][(size_t)idx * 16 + h + 1];
                    *(unsigned*)(SBB + (size_t)(gi * 128 + pp) * 16 + h) = cvt_pk_bf16((float)(cr * br0 - ci * bi0), (float)(cr * br1 - ci * bi1));
                    *(unsigned*)(SBB + (size_t)(gi * 128 + 64 + pp) * 16 + h) = cvt_pk_bf16((float)(cr * bi0 + ci * br0), (float)(cr * bi1 + ci * br1));
                }
#pragma unroll
                for (int h = 0; h < 16; ++h) {
                    SCM[(size_t)(gi * 16 + h) * 128 + pp] = (bf16_t)(cvt_pk_bf16(p.in[I_SCRE][(size_t)(gi * 16 + h) * 64 + pp], 0.f) & 0xffffu);
                    SCM[(size_t)(gi * 16 + h) * 128 + 64 + pp] = (bf16_t)(cvt_pk_bf16(-p.in[I_SCIM][(size_t)(gi * 16 + h) * 64 + pp], 0.f) & 0xffffu);
                }
            }
        }
    }
    SEAM(0);
    if (IN(1)) {
        { pg8::Gemm g{U, (const bf16_t*)(ws + WS_WGU1), D, 0, 0}; pg8::Sched S; S.init(M, 2 * FF, G, blockIdx.x, 1); pg8::EpiSwiglu E{BIG}; pg8::gemm_phase(lds, g, S, E, wave); }
        { pg8::Gemm g{(const bf16_t*)(ws + WS_MN), (const bf16_t*)(ws + WS_WMKV), D, 0, 0}; pg8::Sched S; S.init(2048, 2048, G, (blockIdx.x + G - 44) % G, 1); pg8::EpiMemKV E{(bf16_t*)(ws + WS_MKV), p.out}; pg8::gemm_phase(lds, g, S, E, wave); }
    }
    SEAM(1);
    if (IN(2)) {
        { pg8::Gemm g{BIG, (const bf16_t*)(ws + WS_WD1), FF, 0, 0}; pg8::Sched S; S.init(MP, D, G, blockIdx.x, 1); pg8::EpiDown E{YO, RSQ}; pg8::gemm_phase(lds, g, S, E, wave); }
        { pg8::Gemm g{BIG + (size_t)MP * FF, (const bf16_t*)(ws + WS_WD1), 512, 1024, 1024, FF}; pg8::SchedSplit S{8, 11, G, (int)blockIdx.x}; pg8::EpiSplitAcc E{(float*)(ws + WS_ZS)}; pg8::gemm_phase(lds, g, S, E, wave); }
    }
    SEAM(2);
    if (IN(3)) { mvt_build<bf16_t>((const bf16_t*)(ws + WS_MKV), 2048, 1024, (bf16_t*)(ws + WS_MVT), 8, (size_t)gw * 64 + lane_id(), (size_t)NGW * 64);
        ew_phase<1>(p, p.in[I_F1POST], p.in[I_MIXPRE], gw, NGW, lane_id(), 11); }
    SEAM(3);
    if (IN(4)) { pg8::Gemm g{U, (const bf16_t*)(ws + WS_WIN), D, 0, 0}; pg8::Sched S; S.init(M, NIN5, G, blockIdx.x, 1); pg8::EpiWin E{BIG, p.out}; pg8::gemm_phase(lds, g, S, E, wave); }
    SEAM(4);
    if (IN(5)) {
        const bf16_t* PROJ = BIG;
        constexpr int N_SA = 8 * 64 * (NSEG - 1), N_BP = 8 * 64 * 16, N_MP = 8 * 256 * 4, N_BS = 256, N_MSs = 64;
        {
            const int lane = lane_id();
            const bool xmap = (G % 8 == 0);
            const int wxs = xmap ? (G / 8) * 8 : NGW, wx0 = xmap ? (int)(blockIdx.x >> 3) * 8 + wave : gw;
            for (int r0 = wx0; r0 < (xmap ? 1024 : N_BP); r0 += wxs) {
                const int r = xmap ? ((int)(blockIdx.x & 7) << 10) + r0 : r0;
                const int h = r & 15, c = (r >> 4) & 63, b = r >> 10;
                const int c0 = c >= 8 ? c - 8 : 0; const size_t qrow = (size_t)b * TP + c * 64, krow = (size_t)b * TP + c0 * 64;
                attn_item<4, 64, true, false>(PROJ + qrow * NIN5 + 1024 + h * 64, NIN5, PROJ + krow * NIN5 + 2048 + h * 64, PROJ + krow * NIN5 + 3072 + h * 64, (size_t)64 * NIN5, NIN5, c - c0 + 1,
                                       nullptr, nullptr, 0, 0, false, c * 64, c0 * 64, 0.125f, p.in[I_RELB] + h * 257, OA + qrow * 1024 + h * 64, 1024, wl, lane);
            }
        }
        {
            const int lane = lane_id();
            for (int r = (gw + NGW - 512) % NGW; r < N_SA; r += NGW) {
                const int gi = r & 63, rest = r >> 6, seg = rest % (NSEG - 1), b = rest / (NSEG - 1), bg = b * 64 + gi;
                float s_re = 0.f, s_im = 0.f;
                ssm_run<false>(p, gi, (size_t)b * TP + seg * SEG, SEG / 16, s_re, s_im, wl, lane);
                float* SE = (float*)(ws + WS_SE) + ((size_t)bg * NSEG + seg) * 128; SE[lane] = s_re; SE[64 + lane] = s_im;
            }
        }
        {
            const int lane = lane_id();
            const bool xmap = (G % 8 == 0);
            const int wxs = xmap ? (G / 8) * 8 : NGW, wx0 = xmap ? (int)(blockIdx.x >> 3) * 8 + wave : gw;
            for (int r0 = wx0; r0 < (xmap ? 1024 : N_MP); r0 += wxs) {
                const int r = xmap ? ((int)(blockIdx.x & 7) << 10) + r0 : r0;
                const int h = r & 3, qb = (r >> 2) & 255, b = r >> 10;
                const size_t qrow = (size_t)b * TP + qb * 16; const bf16_t* MKV = (const bf16_t*)(ws + WS_MKV) + (size_t)b * 256 * 2048 + h * 256;
                attn_item<1, 256, false, true>(PROJ + qrow * NIN5 + 4096 + h * 256, NIN5, MKV, MKV + 1024, (size_t)64 * 2048, 2048, 4,
                                         nullptr, nullptr, 0, 0, false, 0, 0, 0.0625f, nullptr, OM + qrow * 1024 + h * 256, 1024, wl, lane, (const bf16_t*)(ws + WS_MVT) + (size_t)(b * 4 + h) * 65536);
            }
        }
        {
            const int lane = lane_id();
            for (int r = (gw + NGW - 1536) % NGW; r < N_BS; r += NGW) {
                const int h = r & 15, b = r >> 4; const size_t qrow = (size_t)MP + b * 16;
                const bf16_t* CK = (const bf16_t*)(ws + WS_CK) + (size_t)b * 512 * 1024 + h * 64; const bf16_t* CV = (const bf16_t*)(ws + WS_CV) + (size_t)b * 512 * 1024 + h * 64;
                attn_item<1, 64, true, false>(PROJ + qrow * NIN5 + 1024 + h * 64, NIN5, CK, CV, (size_t)64 * 1024, 1024, 8,
                                       PROJ + qrow * NIN5 + 2048 + h * 64, PROJ + qrow * NIN5 + 3072 + h * 64, NIN5, 16, true, 4096, 3584, 0.125f, p.in[I_RELB] + h * 257,
                                       OA + qrow * 1024 + h * 64, 1024, wl, lane);
            }
        }
        {
            const int lane = lane_id();
            for (int r = (gw + NGW - 1800) % NGW; r < N_MSs; r += NGW) {
                const int h = r & 3, b = r >> 2; const size_t qrow = (size_t)MP + b * 16;
                const bf16_t* CMK = (const bf16_t*)(ws + WS_CMK) + (size_t)b * 256 * 1024 + h * 256; const bf16_t* CMV = (const bf16_t*)(ws + WS_CMV) + (size_t)b * 256 * 1024 + h * 256;
                attn_item<1, 256, false, true>(PROJ + qrow * NIN5 + 4096 + h * 256, NIN5, CMK, CMV, (size_t)64 * 1024, 1024, 4,
                                         nullptr, nullptr, 0, 0, false, 0, 0, 0.0625f, nullptr, OM + qrow * 1024 + h * 256, 1024, wl, lane, (const bf16_t*)(ws + WS_CMVT) + (size_t)(b * 4 + h) * 65536);
            }
        }
    }
    SEAM(5);
    if (IN(6)) {
        const int lane = lane_id();
        constexpr int N_SB = 8 * 64 * NSEG, N_SS = 16 * 64;
        const float* SAB = (const float*)(ws + WS_SAB);
        for (int it = gw; it < N_SB + N_SS; it += NGW) {
            if (it < N_SB) {
                const int gi = it & 63, seg = (it >> 6) & (NSEG - 1), b = it >> 10, bg = b * 64 + gi;
                const f32x4 ab = *(const f32x4*)(SAB + (size_t)(gi * 64 + lane) * 4);
                float s_re = 0.f, s_im = 0.f; const float* SE = (const float*)(ws + WS_SE) + (size_t)bg * NSEG * 128;
                for (int i = 0; i < seg; ++i) { const float er = SE[i * 128 + lane], ei = SE[i * 128 + 64 + lane];
                    const float nr = fmaf(ab[2], s_re, fmaf(-ab[3], s_im, er)), ni = fmaf(ab[2], s_im, fmaf(ab[3], s_re, ei)); s_re = nr; s_im = ni; }
                ssm_run<true>(p, gi, (size_t)b * TP + seg * SEG, SEG / 16, s_re, s_im, wl, lane);
                if (seg == NSEG - 1) { p.out[O_SRE_P + (size_t)bg * 64 + lane] = s_re; p.out[O_SIM_P + (size_t)bg * 64 + lane] = s_im; }
            } else {
                const int bg = it - N_SB, gi = bg & 63, b = bg >> 6;
                float s_re = p.in[I_SRE][(size_t)bg * 64 + lane], s_im = p.in[I_SIM][(size_t)bg * 64 + lane];
                ssm_run<true>(p, gi, (size_t)MP + b * 16, 1, s_re, s_im, wl, lane);
                p.out[O_SRE_S + (size_t)bg * 64 + lane] = s_re; p.out[O_SIM_S + (size_t)bg * 64 + lane] = s_im;
            }
        }
    }
    SEAM(6);
    if (IN(7)) {
        { pg8::Gemm g{YS, (const bf16_t*)(ws + WS_WGLU), 1024, 0, 0}; pg8::Sched S; S.init(M, 1024, G, blockIdx.x, 1); pg8::EpiGlu E{YS, p.in[I_SBGLU], OS}; pg8::gemm_phase(lds, g, S, E, wave); }
        { pg8::Gemm g{U, (const bf16_t*)(ws + WS_WIN) + (size_t)NIN5 * D, D, 0, 0}; pg8::Sched S; S.init(M, NGATE, G, (blockIdx.x + G - 4) % G, 1); pg8::EpiGate E{BIG};
        pg8::gemm_phase(lds, g, S, E, wave); }
    }
    SEAM(7);
    if (IN(8)) {
        pg8::Gemm g{OS, (const bf16_t*)(ws + WS_WBR), 1024, (size_t)M * 1024 * 2, (size_t)2048 * 1024 * 2}; pg8::Sched S; S.init(M, D, G, blockIdx.x, 3); pg8::EpiBranch E{BIG, U}; pg8::gemm_phase(lds, g, S, E, wave); }
    SEAM(8);
    if (IN(9)) {
        { pg8::Gemm g{U, (const bf16_t*)(ws + WS_WOUT), D, 0, 0}; pg8::Sched S; S.init(MP, D, G, blockIdx.x, 1); pg8::EpiDown E{YO, RSQ}; pg8::gemm_phase(lds, g, S, E, wave); }
        { pg8::Gemm g{U + (size_t)MP * D, (const bf16_t*)(ws + WS_WOUT), 512, 1024, 1024, D}; pg8::SchedSplit S{8, 4, G, (int)blockIdx.x}; pg8::EpiSplitAcc E{(float*)(ws + WS_ZS)}; pg8::gemm_phase(lds, g, S, E, wave); }
    }
    SEAM(9);
    if (IN(10)) ew_phase<2>(p, p.in[I_MIXPOST], p.in[I_F2PRE], gw, NGW, lane_id(), 4);
    SEAM(10);
    if (IN(11)) {
        pg8::Gemm g{U, (const bf16_t*)(ws + WS_WGU2), D, 0, 0}; pg8::Sched S; S.init(M, 2 * FF, G, blockIdx.x, 1); pg8::EpiSwiglu E{BIG}; pg8::gemm_phase(lds, g, S, E, wave); }
    SEAM(11);
    if (IN(12)) {
        { pg8::Gemm g{BIG, (const bf16_t*)(ws + WS_WD2), FF, 0, 0}; pg8::Sched S; S.init(MP, D, G, blockIdx.x, 1); pg8::EpiDown E{YO, RSQ}; pg8::gemm_phase(lds, g, S, E, wave); }
        { pg8::Gemm g{BIG + (size_t)MP * FF, (const bf16_t*)(ws + WS_WD2), 512, 1024, 1024, FF}; pg8::SchedSplit S{8, 11, G, (int)blockIdx.x}; pg8::EpiSplitAcc E{(float*)(ws + WS_ZS)}; pg8::gemm_phase(lds, g, S, E, wave); }
    }
    SEAM(12);
    if (IN(13)) ew_phase<3>(p, p.in[I_F2POST], nullptr, gw, NGW, lane_id(), 11);
#undef IN
#undef SEAM
}

extern "C" void kernel_launch(void* const* d_in, const int* in_sizes, int n_in, void* d_out, int out_size, void* d_ws, size_t ws_size, hipStream_t stream) {
    static int grid = 0;
    if (grid == 0) {
        if (n_in != 40 || ws_size < WS_END) { fprintf(stderr, "kernel_launch: unexpected n_in %d / ws %zu\n", n_in, ws_size); grid = -1; return; }
        int dev = 0, cus = 0, per_cu = 0;
        hipGetDevice(&dev); hipDeviceGetAttribute(&cus, hipDeviceAttributeMultiprocessorCount, dev);
        if (hipFuncSetAttribute((const void*)mega_fwd, hipFuncAttributeMaxDynamicSharedMemorySize, LDS_BYTES) != hipSuccess) { fprintf(stderr, "kernel_launch: hipFuncSetAttribute failed\n"); grid = -1; return; }
        if (hipOccupancyMaxActiveBlocksPerMultiprocessor(&per_cu, (const void*)mega_fwd, 512, LDS_BYTES) != hipSuccess || per_cu < 1) { fprintf(stderr, "kernel_launch: occupancy query says %d\n", per_cu); per_cu = 1; }
        (void)hipGetLastError();
        grid = cus * per_cu;
    }
    if (grid < 0) return;
    if (hipMemsetAsync(d_ws, 0, 16384, stream) != hipSuccess) { fprintf(stderr, "kernel_launch: memset of barrier words failed\n"); return; }
    Params p{};
    for (int i = 0; i < 40; ++i) p.in[i] = (const float*)d_in[i];
    p.out = (float*)d_out; p.ws = (unsigned char*)d_ws; p.ph_lo = 0; p.ph_hi = 14;
    void* args[] = {&p};
    hipError_t e = hipLaunchCooperativeKernel((const void*)mega_fwd, dim3(grid), dim3(512), args, LDS_BYTES, stream);
    if (e != hipSuccess) fprintf(stderr, "cooperative launch failed: %s (grid %d)\n", hipGetErrorString(e), grid);
}
```

```cpp
#include <hip/hip_runtime.h>
#include <hip/hip_cooperative_groups.h>
#include <cstdio>
#include <cstdint>
namespace cg = cooperative_groups;

#define LAS __attribute__((address_space(3)))
typedef unsigned short bf16_t;
typedef short bf16x8 __attribute__((ext_vector_type(8)));
typedef short bf16x4 __attribute__((ext_vector_type(4)));
typedef float f32x4 __attribute__((ext_vector_type(4)));
typedef unsigned u32x4 __attribute__((ext_vector_type(4)));
typedef unsigned u32x2 __attribute__((ext_vector_type(2)));

constexpr int D = 2048, MP = 32768, MS = 256, M = MP + MS, FF = 5632, NIN5 = 5120, NGATE = 6144, TP = 4096;
constexpr float EPS = 1e-6f;
constexpr int SEG = 256, NSEG = TP / SEG;
constexpr size_t O_Y = 0;
constexpr size_t O_ATTK_P = (size_t)M * D;
constexpr size_t O_ATTV_P = O_ATTK_P + 4194304;
constexpr size_t O_MEMK_P = O_ATTV_P + 4194304;
constexpr size_t O_MEMV_P = O_MEMK_P + 2097152;
constexpr size_t O_SRE_P = O_MEMV_P + 2097152;
constexpr size_t O_SIM_P = O_SRE_P + 32768;
constexpr size_t O_ATTK_S = O_SIM_P + 32768;
constexpr size_t O_ATTV_S = O_ATTK_S + 262144;
constexpr size_t O_SRE_S = O_ATTV_S + 262144;
constexpr size_t O_SIM_S = O_SRE_S + 65536;
constexpr size_t MiB = 1u << 20;
constexpr size_t WS_WGU1 = 1 * MiB, WS_WD1 = 45 * MiB, WS_WIN = 67 * MiB, WS_WGLU = 111 * MiB, WS_WMKV = 113 * MiB, WS_WBR = 121 * MiB,
                 WS_WOUT = 133 * MiB, WS_WGU2 = 141 * MiB, WS_WD2 = 185 * MiB;
constexpr size_t WS_YS = 1 * MiB;
constexpr size_t WS_U = 207 * MiB;
constexpr size_t WS_BIG = 336 * MiB;
constexpr size_t WS_YO = 723 * MiB;
constexpr size_t WS_MN = 917 * MiB, WS_MKV = 925 * MiB, WS_CK = 933 * MiB, WS_CV = 949 * MiB, WS_CMK = 965 * MiB, WS_CMV = 973 * MiB;
constexpr size_t WS_RSQ = 981 * MiB;
constexpr size_t WS_SE = 986 * MiB;
constexpr size_t WS_SAB = 990 * MiB;
constexpr size_t WS_SBB = 990 * MiB + 65536;
constexpr size_t WS_SCM = 990 * MiB + 65536 + 262144;
constexpr size_t WS_MVT = 992 * MiB;
constexpr size_t WS_CMVT = 996 * MiB;
constexpr size_t WS_ZS = 691 * MiB;
constexpr size_t WS_END = 1004 * MiB;
constexpr int LDS_BYTES = 147456;
constexpr int WLDS = 16384;

__device__ __forceinline__ unsigned cvt_pk_bf16(float lo, float hi) { unsigned r; asm volatile("s_nop 1\n\tv_cvt_pk_bf16_f32 %0, %1, %2\n\ts_nop 0" : "=v"(r) : "v"(lo), "v"(hi)); return r; }
__device__ __forceinline__ float bf2f(unsigned b) { return __uint_as_float(b << 16); }
__device__ __forceinline__ float bflo(unsigned w) { return __uint_as_float(w << 16); }
__device__ __forceinline__ float bfhi(unsigned w) { return __uint_as_float(w & 0xffff0000u); }
__device__ __forceinline__ float wave_sum(float v) {
#pragma unroll
    for (int o = 1; o < 64; o <<= 1) v += __shfl_xor(v, o);
    return v;
}
__device__ __forceinline__ float sigmoidf_(float x) { return __builtin_amdgcn_rcpf(1.0f + __expf(-x)); }
#define LDS_WAIT() asm volatile("s_waitcnt lgkmcnt(0)" ::: "memory")
__device__ __forceinline__ int lane_id() { int l; asm volatile("v_mbcnt_lo_u32_b32 %0, -1, 0\n\tv_mbcnt_hi_u32_b32 %0, -1, %0" : "=v"(l)); return l; }

namespace pg8 {
constexpr int BM = 256, BK = 64, HALF = 128, HTB = HALF * BK * 2, STAGE_BYTES = 8 * HTB, NXCD = 8, WGM = 8;
__host__ __device__ __forceinline__ int lds_byte(int r, int c) { const int st = (r >> 4) * 2 + (c >> 5), rr = r & 15, cc = c & 31, ob = rr * 64 + cc * 2; return st * 1024 + (ob ^ (((ob >> 9) & 1) << 5)); }
__host__ __device__ __forceinline__ void stage_rc(int b, int& R, int& C) { const int st = b / 1024, sb = b % 1024, swz = sb ^ (((sb >> 9) & 1) << 5); R = (st >> 1) * 16 + swz / 64; C = (st & 1) * 32 + (swz % 64) / 2; }
__host__ __device__ __forceinline__ int perm32(int rho) { const int n = rho >> 4, i = rho & 15; return 8 * (i >> 2) + 4 * n + (i & 3); }

struct Unit { int pm, pn, z; };
struct Gemm { const bf16_t* A; const bf16_t* Bt; int K; size_t zsA, zsB; int ld; };

struct Sched {
    int nM, nN, nwg, G, c, Z;
    __device__ void init(int M_, int N_, int G_, int c_, int Z_) { nM = M_ / BM; nN = N_ / BM; nwg = nM * nN; G = G_; c = c_; Z = Z_; }
    __device__ bool next(int i, Unit& u) const {
        int z = 0, ii = i;
        if (Z > 1) { z = i % Z; ii = i / Z; }
        const long L = (long)ii * G + c; if (L >= nwg) return false;
        int wgid = (int)L; { const int q = nwg / NXCD, r = nwg % NXCD, xcd = wgid % NXCD, off = wgid / NXCD; wgid = (xcd < r ? xcd * (q + 1) : r * (q + 1) + (xcd - r) * q) + off; }
        const int nig = WGM * nN, gid = wgid / nig, fm = gid * WGM, gsz = (nM - fm) < WGM ? (nM - fm) : WGM;
        u.pm = fm + ((wgid % nig) % gsz); u.pn = (wgid % nig) / gsz; u.z = z; return true;
    }
};

template <class Epi, class SchedT>
__device__ __forceinline__ void gemm_phase(LAS unsigned char* lds, const Gemm g, const SchedT& S, const Epi& E, const int wid) {
    const int lane = lane_id(), tid = wid * 64 + lane, wr = wid >> 2, wc = wid & 3, fr = lane & 15, fq = lane >> 4;
    const int K = g.K, nt = K / BK, ld = g.ld ? g.ld : g.K;
    unsigned voffA[2], voffB[2];
#pragma unroll
    for (int i = 0; i < 2; ++i) { int R, C; stage_rc(tid * 16 + i * 8192, R, C); const int Rb = (R & ~31) + perm32(R & 31);
        voffA[i] = (unsigned)(R * ld + C) * 2u; voffB[i] = (unsigned)(Rb * ld + C) * 2u; }
    const size_t kstep = (size_t)(BK * 2);
    const size_t hstep = (size_t)HALF * ld * 2;
    const size_t tstep = 2 * hstep;
    const unsigned ldsw = (unsigned)wid * 1024u;
    const int aoff = lds_byte(wr * 64 + fr, fq * 8), boff = lds_byte(wc * 32 + fr, fq * 8);
#define PG8_SA(b, h) (((b) * 2 + (h)) * HTB)
#define PG8_SB(b, h) ((4 + (b) * 2 + (h)) * HTB)
#define PG8_STAGE(bufoff, gbase, voff) do { _Pragma("unroll") for (int _i = 0; _i < 2; ++_i) \
        __builtin_amdgcn_global_load_lds((const unsigned*)((const char*)(gbase) + (voff)[_i]), (LAS unsigned*)(lds + (bufoff) + ldsw + _i * 8192), 16, 0, 0); } while (0)
#define PG8_LDA(dst, b, h) do { _Pragma("unroll") for (int m = 0; m < 4; ++m) _Pragma("unroll") for (int k = 0; k < 2; ++k) dst[m][k] = *(const LAS bf16x8*)(lds + PG8_SA(b, h) + aoff + m * 2048 + k * 1024); } while (0)
#define PG8_LDB(dst, b, h) do { _Pragma("unroll") for (int n = 0; n < 2; ++n) _Pragma("unroll") for (int k = 0; k < 2; ++k) dst[n][k] = *(const LAS bf16x8*)(lds + PG8_SB(b, h) + boff + n * 2048 + k * 1024); } while (0)
#define PG8_MMA(ai, bj, At, Bt) do { __builtin_amdgcn_s_setprio(1); _Pragma("unroll") for (int m = 0; m < 4; ++m) _Pragma("unroll") for (int n = 0; n < 2; ++n) _Pragma("unroll") for (int k = 0; k < 2; ++k) \
        acc[ai][bj][m][n] = __builtin_amdgcn_mfma_f32_16x16x32_bf16(Bt[n][k], At[m][k], acc[ai][bj][m][n], 0, 0, 0); __builtin_amdgcn_s_setprio(0); } while (0)
#define PG8_WAIT_V(n) asm volatile("s_waitcnt vmcnt(" #n ")" ::: "memory")
#define PG8_WAIT_L(n) asm volatile("s_waitcnt lgkmcnt(" #n ")" ::: "memory")
#define PG8_BAR __builtin_amdgcn_s_barrier()
#define PG8_SCHED __builtin_amdgcn_sched_barrier(0)
    Unit cur, nxt; int ui = 0;
    if (!S.next(0, cur)) return;
    f32x4 acc[2][2][4][2];
#pragma unroll
    for (int a = 0; a < 2; ++a)
#pragma unroll
        for (int b = 0; b < 2; ++b)
#pragma unroll
            for (int m = 0; m < 4; ++m)
#pragma unroll
                for (int n = 0; n < 2; ++n) acc[a][b][m][n] = (f32x4){0.f, 0.f, 0.f, 0.f};
    bf16x8 At[4][2], B0[2][2], B1[2][2];
    const char* cA = (const char*)g.A + (size_t)cur.z * g.zsA + (size_t)cur.pm * tstep; const char* cB = (const char*)g.Bt + (size_t)cur.z * g.zsB + (size_t)cur.pn * tstep;
    PG8_STAGE(PG8_SB(0, 0), cB, voffB); PG8_STAGE(PG8_SB(0, 1), cB + hstep, voffB); PG8_STAGE(PG8_SA(0, 0), cA, voffA); PG8_STAGE(PG8_SA(0, 1), cA + hstep, voffA);
    if (wr == 1) PG8_BAR;
    PG8_WAIT_V(2); PG8_BAR;
    PG8_STAGE(PG8_SB(1, 0), cB + kstep, voffB); PG8_STAGE(PG8_SA(1, 0), cA + kstep, voffA); PG8_STAGE(PG8_SB(1, 1), cB + hstep + kstep, voffB);
    PG8_WAIT_V(6); PG8_BAR;
    for (;;) {
        const bool has_next = S.next(ui + 1, nxt);
        const char* nA = has_next ? (const char*)g.A + (size_t)nxt.z * g.zsA + (size_t)nxt.pm * tstep : cA; const char* nB = has_next ? (const char*)g.Bt + (size_t)nxt.z * g.zsB + (size_t)nxt.pn * tstep : cB;
        for (int t = 0; t < nt; t += 2) {
            const bool last = (t == nt - 2);
            const char* a1 = cA + (size_t)(t + 1) * kstep;
            const char* a2 = last ? nA : cA + (size_t)(t + 2) * kstep; const char* b2 = last ? nB : cB + (size_t)(t + 2) * kstep;
            const char* a3 = a2 + kstep; const char* b3 = b2 + kstep;
            PG8_LDB(B0, 0, 0); PG8_LDB(B1, 0, 1); PG8_SCHED; PG8_LDA(At, 0, 0); PG8_STAGE(PG8_SA(1, 1), a1 + hstep, voffA);
            PG8_WAIT_V(8); PG8_WAIT_L(0); PG8_BAR; PG8_MMA(0, 0, At, B0); PG8_MMA(0, 1, At, B1); PG8_BAR; PG8_SCHED;
            PG8_LDA(At, 0, 1); PG8_STAGE(PG8_SB(0, 0), b2, voffB); PG8_STAGE(PG8_SB(0, 1), b2 + hstep, voffB); PG8_STAGE(PG8_SA(0, 0), a2, voffA);
            PG8_WAIT_V(8); PG8_WAIT_L(0); PG8_BAR; PG8_MMA(1, 0, At, B0); PG8_MMA(1, 1, At, B1); PG8_BAR; PG8_SCHED;
            PG8_LDB(B0, 1, 0); PG8_LDB(B1, 1, 1); PG8_SCHED; PG8_LDA(At, 1, 0); PG8_STAGE(PG8_SA(0, 1), a2 + hstep, voffA);
            PG8_WAIT_V(8); PG8_WAIT_L(0); PG8_BAR; PG8_MMA(0, 0, At, B0); PG8_MMA(0, 1, At, B1); PG8_BAR; PG8_SCHED;
            PG8_LDA(At, 1, 1); PG8_STAGE(PG8_SB(1, 0), b3, voffB); PG8_STAGE(PG8_SB(1, 1), b3 + hstep, voffB); PG8_STAGE(PG8_SA(1, 0), a3, voffA);
            PG8_WAIT_V(8); PG8_WAIT_L(0); PG8_BAR; PG8_MMA(1, 0, At, B0); PG8_MMA(1, 1, At, B1); PG8_BAR; PG8_SCHED;
        }
        if (wr == 0) PG8_BAR;
        E(acc, cur, wr, wc, fr, fq);
        if (!has_next) break;
#pragma unroll
        for (int a = 0; a < 2; ++a)
#pragma unroll
            for (int b = 0; b < 2; ++b)
#pragma unroll
                for (int m = 0; m < 4; ++m)
#pragma unroll
                    for (int n = 0; n < 2; ++n) acc[a][b][m][n] = (f32x4){0.f, 0.f, 0.f, 0.f};
        cur = nxt; cA = nA; cB = nB; ++ui;
        if (wr == 1) PG8_BAR;
    }
    PG8_WAIT_V(0);
    PG8_BAR;
#undef PG8_SA
#undef PG8_SB
#undef PG8_STAGE
#undef PG8_LDA
#undef PG8_LDB
#undef PG8_MMA
#undef PG8_WAIT_V
#undef PG8_WAIT_L
#undef PG8_BAR
#undef PG8_SCHED
}

struct SchedSplit {
    int nN, S, G, c;
    __device__ bool next(int i, Unit& u) const { const int L = i * G + c; if (L >= nN * S) return false; u.pm = 0; u.pn = L % nN; u.z = L / nN; return true; }
};
typedef const f32x4 (&AccRef)[2][2][4][2];
__device__ __forceinline__ u32x4 pack8(const f32x4 a, const f32x4 b) { u32x4 w; w.x = cvt_pk_bf16(a[0], a[1]); w.y = cvt_pk_bf16(a[2], a[3]); w.z = cvt_pk_bf16(b[0], b[1]); w.w = cvt_pk_bf16(b[2], b[3]); return w; }

struct EpiSwiglu {
    bf16_t* ACT;
    __device__ __forceinline__ void operator()(AccRef acc, const Unit& u, int wr, int wc, int fr, int fq) const {
        const int row0 = u.pm * BM + wr * 64 + fr, col = u.pn * 128 + wc * 32 + 8 * fq;
#pragma unroll
        for (int ai = 0; ai < 2; ++ai)
#pragma unroll
            for (int m = 0; m < 4; ++m) {
                f32x4 r0, r1;
#pragma unroll
                for (int j = 0; j < 4; ++j) { const float g0 = acc[ai][0][m][0][j], g1 = acc[ai][0][m][1][j];
                    r0[j] = g0 * sigmoidf_(g0) * acc[ai][1][m][0][j]; r1[j] = g1 * sigmoidf_(g1) * acc[ai][1][m][1][j]; }
                *(u32x4*)(ACT + (size_t)(row0 + ai * HALF + m * 16) * FF + col) = pack8(r0, r1);
            }
    }
};
struct EpiDown {
    bf16_t* Y; float* RSQ;
    __device__ __forceinline__ void operator()(AccRef acc, const Unit& u, int wr, int wc, int fr, int fq) const {
        const int row0 = u.pm * BM + wr * 64 + fr, col = u.pn * BM + wc * 32 + 8 * fq;
#pragma unroll
        for (int ai = 0; ai < 2; ++ai)
#pragma unroll
            for (int m = 0; m < 4; ++m) { const int row = row0 + ai * HALF + m * 16; float s = 0.f;
#pragma unroll
                for (int bj = 0; bj < 2; ++bj) { const f32x4 a = acc[ai][bj][m][0], b = acc[ai][bj][m][1];
                    s += (a[0] * a[0] + a[1] * a[1]) + (a[2] * a[2] + a[3] * a[3]) + (b[0] * b[0] + b[1] * b[1]) + (b[2] * b[2] + b[3] * b[3]);
                    *(u32x4*)(Y + (size_t)row * D + col + bj * HALF) = pack8(a, b); }
                s += __shfl_xor(s, 16); s += __shfl_xor(s, 32);
                if (fq == 0) RSQ[(size_t)row * 32 + u.pn * 4 + wc] = s; }
    }
};
struct EpiSplitAcc {
    float* ZS;
    __device__ __forceinline__ void operator()(AccRef acc, const Unit& u, int wr, int wc, int fr, int fq) const {
        const int row0 = wr * 64 + fr, col = u.pn * BM + wc * 32 + 8 * fq;
#pragma unroll
        for (int ai = 0; ai < 2; ++ai)
#pragma unroll
            for (int m = 0; m < 4; ++m) { float* rp = ZS + (size_t)(row0 + ai * HALF + m * 16) * D + col;
#pragma unroll
                for (int bj = 0; bj < 2; ++bj)
#pragma unroll
                    for (int n = 0; n < 2; ++n) *(f32x4*)(rp + (size_t)u.z * 256 * D + bj * HALF + 4 * n) = acc[ai][bj][m][n]; }
    }
};
struct EpiWin {
    bf16_t* PROJ; float* out;
    __device__ __forceinline__ void operator()(AccRef acc, const Unit& u, int wr, int wc, int fr, int fq) const {
        const int row0 = u.pm * BM + wr * 64 + fr, col = u.pn * BM + wc * 32 + 8 * fq;
        const bool kv = (u.pn >= 8 && u.pn < 16), isk = u.pn < 12, samp = (u.pm == 128), tailp = (!samp && (u.pm & 15) >= 14);
        const int kcol0 = col - (isk ? 2048 : 3072);
#pragma unroll
        for (int ai = 0; ai < 2; ++ai)
#pragma unroll
            for (int m = 0; m < 4; ++m) { const int row = row0 + ai * HALF + m * 16;
#pragma unroll
                for (int bj = 0; bj < 2; ++bj) { const f32x4 a = acc[ai][bj][m][0], b = acc[ai][bj][m][1];
                    *(u32x4*)(PROJ + (size_t)row * NIN5 + col + bj * HALF) = pack8(a, b);
                    if (kv && (samp || tailp)) {
                        float* dst;
                        if (samp) dst = out + (isk ? O_ATTK_S : O_ATTV_S) + (size_t)(row - MP) * 1024 + kcol0 + bj * HALF;
                        else { const int bb = row >> 12, t = row & 4095; dst = out + (isk ? O_ATTK_P : O_ATTV_P) + (size_t)(bb * 512 + t - 3584) * 1024 + kcol0 + bj * HALF; }
                        *(f32x4*)dst = a; *(f32x4*)(dst + 4) = b; } } }
    }
};
struct EpiMemKV {
    bf16_t* MKV; float* out;
    __device__ __forceinline__ void operator()(AccRef acc, const Unit& u, int wr, int wc, int fr, int fq) const {
        const int row0 = u.pm * BM + wr * 64 + fr, col = u.pn * BM + wc * 32 + 8 * fq;
        const bool isk = u.pn < 4; float* ob = out + (isk ? O_MEMK_P : O_MEMV_P) + (col - (isk ? 0 : 1024));
#pragma unroll
        for (int ai = 0; ai < 2; ++ai)
#pragma unroll
            for (int m = 0; m < 4; ++m) { const int row = row0 + ai * HALF + m * 16;
#pragma unroll
                for (int bj = 0; bj < 2; ++bj) { const f32x4 a = acc[ai][bj][m][0], b = acc[ai][bj][m][1];
                    *(u32x4*)(MKV + (size_t)row * 2048 + col + bj * HALF) = pack8(a, b);
                    float* dst = ob + (size_t)row * 1024 + bj * HALF; *(f32x4*)dst = a; *(f32x4*)(dst + 4) = b; } }
    }
};
struct EpiGate {
    bf16_t* G;
    __device__ __forceinline__ void operator()(AccRef acc, const Unit& u, int wr, int wc, int fr, int fq) const {
        const int row0 = u.pm * BM + wr * 64 + fr, col = u.pn * BM + wc * 32 + 8 * fq;
#pragma unroll
        for (int ai = 0; ai < 2; ++ai)
#pragma unroll
            for (int m = 0; m < 4; ++m) { const int row = row0 + ai * HALF + m * 16;
#pragma unroll
                for (int bj = 0; bj < 2; ++bj) { const f32x4 a = acc[ai][bj][m][0], b = acc[ai][bj][m][1];
                    *(u32x4*)(G + (size_t)row * NGATE + col + bj * HALF) = pack8(a, b); } }
    }
};
__device__ __forceinline__ void unpack8(const u32x4 w, f32x4& a, f32x4& b) { a[0] = bflo(w.x); a[1] = bfhi(w.x); a[2] = bflo(w.y); a[3] = bfhi(w.y); b[0] = bflo(w.z); b[1] = bfhi(w.z); b[2] = bflo(w.w); b[3] = bfhi(w.w); }
struct EpiGlu {
    const bf16_t* YS; const float* bias; bf16_t* OS;
    __device__ __forceinline__ void operator()(AccRef acc, const Unit& u, int wr, int wc, int fr, int fq) const {
        const int row0 = u.pm * BM + wr * 64 + fr, col = u.pn * BM + wc * 32 + 8 * fq;
#pragma unroll
        for (int ai = 0; ai < 2; ++ai)
#pragma unroll
            for (int m = 0; m < 4; ++m) { const int row = row0 + ai * HALF + m * 16;
#pragma unroll
                for (int bj = 0; bj < 2; ++bj) { f32x4 a = acc[ai][bj][m][0], b = acc[ai][bj][m][1];
                    const size_t off = (size_t)row * 1024 + col + bj * HALF;
                    const f32x4 b0 = *(const f32x4*)(bias + col + bj * HALF), b1 = *(const f32x4*)(bias + col + bj * HALF + 4);
                    f32x4 y0, y1; unpack8(*(const volatile u32x4*)(YS + off), y0, y1);
#pragma unroll
                    for (int j = 0; j < 4; ++j) { a[j] = y0[j] * sigmoidf_(a[j] + b0[j]); b[j] = y1[j] * sigmoidf_(b[j] + b1[j]); }
                    *(u32x4*)(OS + off) = pack8(a, b); } }
    }
};
struct EpiBranch {
    const bf16_t* G; bf16_t* MG;
    __device__ __forceinline__ void operator()(AccRef acc, const Unit& u, int wr, int wc, int fr, int fq) const {
        const int row0 = u.pm * BM + wr * 64 + fr, col = u.pn * BM + wc * 32 + 8 * fq;
#pragma unroll
        for (int ai = 0; ai < 2; ++ai)
#pragma unroll
            for (int m = 0; m < 4; ++m) { const int row = row0 + ai * HALF + m * 16;
#pragma unroll
                for (int bj = 0; bj < 2; ++bj) { f32x4 a = acc[ai][bj][m][0], b = acc[ai][bj][m][1];
                    f32x4 g0, g1; unpack8(*(const volatile u32x4*)(G + (size_t)row * NGATE + u.z * 2048 + col + bj * HALF), g0, g1);
                    bf16_t* mp = MG + (size_t)row * D + col + bj * HALF;
#pragma unroll
                    for (int j = 0; j < 4; ++j) { a[j] = a[j] * sigmoidf_(g0[j]); b[j] = b[j] * sigmoidf_(g1[j]); }
                    if (u.z > 0) { f32x4 o0, o1; unpack8(*(const volatile u32x4*)mp, o0, o1); a = a + o0; b = b + o1; }
                    *(volatile u32x4*)mp = pack8(a, b); } }
    }
};
}

struct Params { const float* in[40]; float* out; unsigned char* ws; int ph_lo, ph_hi; };
enum { I_XP = 0, I_XS, I_MEMP, I_CAK, I_CAV, I_CMK, I_CMV, I_SRE, I_SIM, I_F1PRE, I_F1POST, I_F1G, I_F1U, I_F1D, I_MIXPRE, I_MIXPOST, I_WIN,
       I_SARE, I_SAIM, I_SLDT, I_SBRE, I_SBIM, I_SCRE, I_SCIM, I_SD, I_SWGLU, I_SBGLU, I_RELB, I_MEMNORM, I_WMK, I_WMV, I_WBS, I_WBA, I_WBM, I_WOUT,
       I_F2PRE, I_F2POST, I_F2G, I_F2U, I_F2D };

__device__ __forceinline__ void tr_item(const float* W, int K, int N, bf16_t* WT, int row_off, int inter, LAS float* scr, int item, int lane) {
    const int nblk = N / 32, kb = item / nblk, nb = item % nblk, k0 = 64 * kb, n0 = 32 * nb;
#pragma unroll 8
    for (int i = 0; i < 32; ++i) { const int kk = 2 * i + (lane >> 5); scr[kk * 33 + (lane & 31)] = __builtin_nontemporal_load(W + (size_t)(k0 + kk) * N + n0 + (lane & 31)); }
    LDS_WAIT();
    const int c = lane & 7;
#pragma unroll
    for (int j = 0; j < 4; ++j) { const int n = (lane >> 3) + 8 * j; const LAS float* s = scr + (8 * c) * 33 + n;
        u32x4 o; o.x = cvt_pk_bf16(s[0 * 33], s[1 * 33]); o.y = cvt_pk_bf16(s[2 * 33], s[3 * 33]); o.z = cvt_pk_bf16(s[4 * 33], s[5 * 33]); o.w = cvt_pk_bf16(s[6 * 33], s[7 * 33]);
        const int col = n0 + n; const int drow = inter ? (((col >> 7) << 8) + (col & 127) + row_off) : (row_off + col);
        *(u32x4*)(WT + (size_t)drow * K + k0 + 8 * c) = o; }
    LDS_WAIT();
}
__device__ __forceinline__ void rms_row_to_bf16(const float* xrow, const float* gain, bf16_t* orow, int lane) {
    f32x4 v[8]; float s = 0.f;
#pragma unroll
    for (int j = 0; j < 8; ++j) { v[j] = __builtin_nontemporal_load((const f32x4*)(xrow + 4 * lane + 256 * j)); s += (v[j][0] * v[j][0] + v[j][1] * v[j][1]) + (v[j][2] * v[j][2] + v[j][3] * v[j][3]); }
    const float rs = rsqrtf(wave_sum(s) * (1.0f / D) + EPS);
#pragma unroll
    for (int j = 0; j < 8; ++j) { const f32x4 gg = *(const f32x4*)(gain + 4 * lane + 256 * j);
        u32x2 w; w.x = cvt_pk_bf16(v[j][0] * rs * gg[0], v[j][1] * rs * gg[1]); w.y = cvt_pk_bf16(v[j][2] * rs * gg[2], v[j][3] * rs * gg[3]);
        *(u32x2*)(orow + 4 * lane + 256 * j) = w; }
}
__device__ __forceinline__ void cvt_copy(const float* src, bf16_t* dst, size_t n, int gw, int NGW, int lane) {
    for (size_t i = ((size_t)gw * 64 + lane) * 8; i < n; i += (size_t)NGW * 512) {
        const f32x4 a = __builtin_nontemporal_load((const f32x4*)(src + i)), b = __builtin_nontemporal_load((const f32x4*)(src + i + 4));
        *(u32x4*)(dst + i) = pg8::pack8(a, b); }
}


__device__ __forceinline__ int vpos_of(int key) { return (key >> 5) * 32 + ((key >> 2) & 3) * 8 + ((key >> 4) & 1) * 4 + (key & 3); }
template <class T> __device__ __forceinline__ void mvt_build(const T* src, int spitch, int scol0, bf16_t* dst, int nb, size_t gtid, size_t nthr) {
    for (size_t idx = gtid; idx < (size_t)nb * 4096; idx += nthr) {
        const int d = (int)(idx & 63), dc = (int)((idx >> 6) & 3), kb = (int)((idx >> 8) & 3), h = (int)((idx >> 10) & 3), b = (int)(idx >> 12);
        const T* sp = src + ((size_t)b * 256 + kb * 64) * spitch + scol0 + h * 256 + dc * 64 + d;
        bf16_t* dp = dst + ((((size_t)(b * 4 + h) * 4 + kb) * 4 + dc) * 64 + d) * 64;
#pragma unroll
        for (int c = 0; c < 8; ++c) { const int t = c >> 2, g = c & 3; float v[8];
#pragma unroll
            for (int i = 0; i < 8; ++i) { const int key = 32 * t + 16 * (i >> 2) + 4 * g + (i & 3);
                if constexpr (sizeof(T) == 4) v[i] = (float)sp[(size_t)key * spitch]; else v[i] = bf2f(sp[(size_t)key * spitch]); }
            u32x4 w; w.x = cvt_pk_bf16(v[0], v[1]); w.y = cvt_pk_bf16(v[2], v[3]); w.z = cvt_pk_bf16(v[4], v[5]); w.w = cvt_pk_bf16(v[6], v[7]);
            *(u32x4*)(dp + 8 * c) = w; }
    }
}

template <int MODE>
__device__ __forceinline__ void ew_phase(const Params& p, const float* gpost, const float* gpre, int gw, int NGW, int lane, int nsplit) {
    float* H = p.out; const bf16_t* Y = (const bf16_t*)(p.ws + WS_YO); const float* RSQ = (const float*)(p.ws + WS_RSQ); bf16_t* U = (bf16_t*)(p.ws + WS_U);
    const float c = (MODE == 2) ? 1.0f : 0.5f;
    for (int row = gw; row < M; row += NGW) {
        const float* hin = (MODE == 1) ? (row < MP ? p.in[I_XP] + (size_t)row * D : p.in[I_XS] + (size_t)(row - MP) * D) : H + (size_t)row * D;
        f32x4 yv[8]; float part = 0.f;
        if (row < MP) {
            part = lane < 32 ? *(const volatile float*)(RSQ + (size_t)row * 32 + lane) : 0.f;
#pragma unroll
            for (int j = 0; j < 8; ++j) { const u32x2 yw = __builtin_nontemporal_load((const u32x2*)(Y + (size_t)row * D + 4 * lane + 256 * j)); yv[j] = (f32x4){bflo(yw.x), bfhi(yw.x), bflo(yw.y), bfhi(yw.y)}; }
        } else {
            const float* zr = (const float*)(p.ws + WS_ZS) + (size_t)(row - MP) * D;
#pragma unroll
            for (int j = 0; j < 8; ++j) { f32x4 a = (f32x4){0.f, 0.f, 0.f, 0.f};
                for (int sl = 0; sl < nsplit; ++sl) { const u32x4 t = *(const volatile u32x4*)(zr + (size_t)sl * 256 * D + 4 * lane + 256 * j); a[0] += __uint_as_float(t.x); a[1] += __uint_as_float(t.y); a[2] += __uint_as_float(t.z); a[3] += __uint_as_float(t.w); }
                yv[j] = a; part += (a[0] * a[0] + a[1] * a[1]) + (a[2] * a[2] + a[3] * a[3]); }
        }
        const float rs = rsqrtf(wave_sum(part) * (1.0f / D) + EPS) * c;
        f32x4 hv[8]; float ss = 0.f;
#pragma unroll
        for (int j = 0; j < 8; ++j) { const int col = 4 * lane + 256 * j;
            const f32x4 h4 = __builtin_nontemporal_load((const f32x4*)(hin + col)); const f32x4 g4 = *(const f32x4*)(gpost + col);
            f32x4 hn; hn[0] = h4[0] + yv[j][0] * rs * g4[0]; hn[1] = h4[1] + yv[j][1] * rs * g4[1]; hn[2] = h4[2] + yv[j][2] * rs * g4[2]; hn[3] = h4[3] + yv[j][3] * rs * g4[3];
            hv[j] = hn; ss += (hn[0] * hn[0] + hn[1] * hn[1]) + (hn[2] * hn[2] + hn[3] * hn[3]);
            __builtin_nontemporal_store(hn, (f32x4*)(H + (size_t)row * D + col)); }
        if (MODE != 3) {
            const float rs2 = rsqrtf(wave_sum(ss) * (1.0f / D) + EPS);
#pragma unroll
            for (int j = 0; j < 8; ++j) { const int col = 4 * lane + 256 * j; const f32x4 gg = *(const f32x4*)(gpre + col);
                u32x2 w; w.x = cvt_pk_bf16(hv[j][0] * rs2 * gg[0], hv[j][1] * rs2 * gg[1]); w.y = cvt_pk_bf16(hv[j][2] * rs2 * gg[2], hv[j][3] * rs2 * gg[3]);
                *(u32x2*)(U + (size_t)row * D + col) = w; }
        }
    }
}

template <int NQ, int HD, bool BIAS, bool VTG>
__device__ __forceinline__ void attn_item(const bf16_t* Q, int qpitch, const bf16_t* K0, const bf16_t* V0, size_t kbstride, int pitch, int nreg,
                                          const bf16_t* Ks, const bf16_t* Vs, int pitch_s, int nvalid_s, bool has_s,
                                          int qpos0, int kpos_base, float scale, const float* bias_g, bf16_t* O, int opitch, LAS unsigned char* wl, int lane, const bf16_t* VT = nullptr) {
    const int fr = lane & 15, g = lane >> 4;
    LAS float* bl = (LAS float*)(wl + 9216);
    LAS bf16_t* vt = (LAS bf16_t*)wl;
    if (BIAS) { for (int i = lane; i < 257; i += 64) bl[i] = bias_g[i]; }
    bf16x8 qf[NQ][HD / 32];
#pragma unroll
    for (int nq = 0; nq < NQ; ++nq)
#pragma unroll
        for (int kd = 0; kd < HD / 32; ++kd) qf[nq][kd] = *(const bf16x8*)(Q + (size_t)(16 * nq + fr) * qpitch + 32 * kd + 8 * g);
    float mrow[NQ], lrow[NQ]; f32x4 o[HD / 16][NQ];
#pragma unroll
    for (int nq = 0; nq < NQ; ++nq) { mrow[nq] = -1e30f; lrow[nq] = 0.f;
#pragma unroll
        for (int md = 0; md < HD / 16; ++md) o[md][nq] = (f32x4){0.f, 0.f, 0.f, 0.f}; }
    LDS_WAIT();
    const int nkb = nreg + (has_s ? 1 : 0);
    const int vpos = (lane >> 5) * 32 + ((lane >> 2) & 3) * 8 + ((lane >> 4) & 1) * 4 + (lane & 3);
    for (int kb = 0; kb < nkb; ++kb) {
        const bool sp = kb >= nreg;
        const bf16_t* Kp = sp ? Ks : K0 + (size_t)kb * kbstride; const bf16_t* Vp = sp ? Vs : V0 + (size_t)kb * kbstride;
        const int pt = sp ? pitch_s : pitch, nv = sp ? nvalid_s : 64;
        f32x4 st[4][NQ];
#pragma unroll
        for (int mk = 0; mk < 4; ++mk) {
#pragma unroll
            for (int nq = 0; nq < NQ; ++nq) st[mk][nq] = (f32x4){0.f, 0.f, 0.f, 0.f};
            const bool kok = (16 * mk + fr) < nv;
#pragma unroll
            for (int kd = 0; kd < HD / 32; ++kd) {
                bf16x8 kf = (bf16x8){0, 0, 0, 0, 0, 0, 0, 0};
                if (kok) kf = *(const bf16x8*)(Kp + (size_t)(16 * mk + fr) * pt + 32 * kd + 8 * g);
#pragma unroll
                for (int nq = 0; nq < NQ; ++nq) st[mk][nq] = __builtin_amdgcn_mfma_f32_16x16x32_bf16(kf, qf[nq][kd], st[mk][nq], 0, 0, 0);
            }
        }
        __builtin_amdgcn_sched_barrier(0); asm volatile("s_nop 15" ::: "memory"); __builtin_amdgcn_sched_barrier(0);
        constexpr int NPRE = (NQ == 4) ? 4 : 8;
        u32x4 vpre[8];
        if (!VTG && HD == 64) { const bool kvok0 = lane < nv; const bf16_t* vrow0 = Vp + (size_t)lane * pt;
#pragma unroll
            for (int cch = 0; cch < NPRE; ++cch) { vpre[cch] = (u32x4){0u, 0u, 0u, 0u}; if (kvok0) vpre[cch] = *(const u32x4*)(vrow0 + 8 * cch); } }
        const bool farb = BIAS && (qpos0 - (kpos_base + 64 * kb + 63) >= 128);
        const float bfar = BIAS ? bl[256] : 0.f;
        bf16x8 pb[2][NQ];
#pragma unroll
        for (int nq = 0; nq < NQ; ++nq) {
            const int qpos = qpos0 + 16 * nq + fr;
            float mx = -1e30f;
#pragma unroll
            for (int mk = 0; mk < 4; ++mk)
#pragma unroll
                for (int j = 0; j < 4; ++j) { const int key = 16 * mk + 4 * g + j; float s = st[mk][nq][j] * scale;
                    if (BIAS) { if (farb) s += bfar; else { int dd = qpos - (kpos_base + 64 * kb + key); dd = dd < -128 ? -128 : (dd > 128 ? 128 : dd); s += bl[dd + 128]; } }
                    if (key >= nv) s = -1e30f;
                    st[mk][nq][j] = s; mx = fmaxf(mx, s); }
            mx = fmaxf(mx, __shfl_xor(mx, 16)); mx = fmaxf(mx, __shfl_xor(mx, 32));
            const float mnew = fmaxf(mrow[nq], mx), alpha = __expf(mrow[nq] - mnew);
            float ps = 0.f;
#pragma unroll
            for (int mk = 0; mk < 4; ++mk)
#pragma unroll
                for (int j = 0; j < 4; ++j) { const float pv = __expf(st[mk][nq][j] - mnew); st[mk][nq][j] = pv; ps += pv; }
            ps += __shfl_xor(ps, 16); ps += __shfl_xor(ps, 32);
            lrow[nq] = lrow[nq] * alpha + ps; mrow[nq] = mnew;
#pragma unroll
            for (int md = 0; md < HD / 16; ++md) o[md][nq] = o[md][nq] * alpha;
#pragma unroll
            for (int t = 0; t < 2; ++t) { u32x4 w;
                w.x = cvt_pk_bf16(st[2 * t][nq][0], st[2 * t][nq][1]); w.y = cvt_pk_bf16(st[2 * t][nq][2], st[2 * t][nq][3]);
                w.z = cvt_pk_bf16(st[2 * t + 1][nq][0], st[2 * t + 1][nq][1]); w.w = cvt_pk_bf16(st[2 * t + 1][nq][2], st[2 * t + 1][nq][3]);
                pb[t][nq] = __builtin_bit_cast(bf16x8, w); }
        }
#pragma unroll
        for (int dc = 0; dc < HD / 64; ++dc) {
            if (VTG) {
                const bf16_t* vtile = VT + (size_t)(kb * (HD / 64) + dc) * 4096;
#pragma unroll
                for (int md = 0; md < 4; ++md)
#pragma unroll
                    for (int t = 0; t < 2; ++t) { const bf16x8 va = *(const bf16x8*)(vtile + (16 * md + fr) * 64 + (t * 4 + g) * 8);
#pragma unroll
                        for (int nq = 0; nq < NQ; ++nq) o[4 * dc + md][nq] = __builtin_amdgcn_mfma_f32_16x16x32_bf16(va, pb[t][nq], o[4 * dc + md][nq], 0, 0, 0); }
                asm volatile("" ::: "memory");
                continue;
            }
            const bool kvok = lane < nv;
            const bf16_t* vrow = Vp + (size_t)lane * pt + 64 * dc;
#pragma unroll
            for (int cch = 0; cch < 8; ++cch) {
                u32x4 vv = (u32x4){0u, 0u, 0u, 0u};
                if (HD == 64 && cch < NPRE) vv = vpre[cch]; else if (kvok) vv = *(const u32x4*)(vrow + 8 * cch);
                vt[(8 * cch + 0) * 72 + vpos] = (bf16_t)(vv.x & 0xffffu); vt[(8 * cch + 1) * 72 + vpos] = (bf16_t)(vv.x >> 16);
                vt[(8 * cch + 2) * 72 + vpos] = (bf16_t)(vv.y & 0xffffu); vt[(8 * cch + 3) * 72 + vpos] = (bf16_t)(vv.y >> 16);
                vt[(8 * cch + 4) * 72 + vpos] = (bf16_t)(vv.z & 0xffffu); vt[(8 * cch + 5) * 72 + vpos] = (bf16_t)(vv.z >> 16);
                vt[(8 * cch + 6) * 72 + vpos] = (bf16_t)(vv.w & 0xffffu); vt[(8 * cch + 7) * 72 + vpos] = (bf16_t)(vv.w >> 16);
            }
            LDS_WAIT();
#pragma unroll
            for (int md = 0; md < 4; ++md)
#pragma unroll
                for (int t = 0; t < 2; ++t) { const bf16x8 va = *(const LAS bf16x8*)(wl + (16 * md + fr) * 144 + (t * 4 + g) * 16);
#pragma unroll
                    for (int nq = 0; nq < NQ; ++nq) o[4 * dc + md][nq] = __builtin_amdgcn_mfma_f32_16x16x32_bf16(va, pb[t][nq], o[4 * dc + md][nq], 0, 0, 0); }
            LDS_WAIT();
        }
    }
    __builtin_amdgcn_sched_barrier(0); asm volatile("s_nop 15" ::: "memory"); __builtin_amdgcn_sched_barrier(0);
#pragma unroll
    for (int nq = 0; nq < NQ; ++nq) { const float inv = 1.0f / lrow[nq];
#pragma unroll
        for (int md = 0; md < HD / 16; ++md) { const f32x4 v = o[md][nq] * inv; u32x2 w; w.x = cvt_pk_bf16(v[0], v[1]); w.y = cvt_pk_bf16(v[2], v[3]);
            *(u32x2*)(O + (size_t)(16 * nq + fr) * opitch + 16 * md + 4 * g) = w; } }
}

__device__ __forceinline__ float gelu_tanh(float x) { const float z = 0.7978845608028654f * (x + 0.044715f * x * x * x); const float e = __expf(2.0f * z); return 0.5f * x * (2.0f - 2.0f * __builtin_amdgcn_rcpf(1.0f + e)); }
template <bool FULL>
__device__ __forceinline__ void ssm_run(const Params& p, int gi, size_t row0, int nsub, float& s_re, float& s_im, LAS unsigned char* wl, int lane) {
    const int fr = lane & 15, g = lane >> 4;
    const bf16_t* PROJ = (const bf16_t*)(p.ws + WS_BIG); bf16_t* YS = (bf16_t*)(p.ws + WS_YS);
    const float* SAB = (const float*)(p.ws + WS_SAB); const bf16_t* SBB = (const bf16_t*)(p.ws + WS_SBB); const bf16_t* SCM = (const bf16_t*)(p.ws + WS_SCM);
    const f32x4 ab = *(const f32x4*)(SAB + (size_t)(gi * 64 + lane) * 4);
    const float a_re = ab[0], a_im = ab[1];
    bf16x4 bbf[8];
#pragma unroll
    for (int t = 0; t < 8; ++t) bbf[t] = *(const bf16x4*)(SBB + (size_t)(gi * 128 + 16 * t + fr) * 16 + 4 * g);
    bf16x8 cmf[4]; float dval = 0.f;
    if (FULL) {
#pragma unroll
        for (int kk = 0; kk < 4; ++kk) cmf[kk] = *(const bf16x8*)(SCM + (size_t)(gi * 16 + fr) * 128 + 32 * kk + 8 * g);
        dval = p.in[I_SD][gi * 16 + fr];
    }
    LAS float* BUl = (LAS float*)wl;
    LAS bf16_t* Sl = (LAS bf16_t*)(wl + 8448);
    bf16x4 uf_nx = *(const bf16x4*)(PROJ + (row0 + fr) * NIN5 + gi * 16 + 4 * g);
    for (int sc = 0; sc < nsub; ++sc) {
        const size_t t0 = row0 + 16 * sc;
        const bf16x4 uf = uf_nx;
        if (sc + 1 < nsub) uf_nx = *(const bf16x4*)(PROJ + (t0 + 16 + fr) * NIN5 + gi * 16 + 4 * g);
        bf16_t upre[4];
        if (FULL) {
#pragma unroll
            for (int j = 0; j < 4; ++j) upre[j] = PROJ[(t0 + 4 * g + j) * NIN5 + gi * 16 + fr];
        }
        f32x4 bu[8];
#pragma unroll
        for (int t = 0; t < 8; ++t) bu[t] = __builtin_amdgcn_mfma_f32_16x16x16bf16_1k(bbf[t], uf, (f32x4){0.f, 0.f, 0.f, 0.f}, 0, 0, 0);
        __builtin_amdgcn_sched_barrier(0); asm volatile("s_nop 15\n\ts_nop 15" ::: "memory"); __builtin_amdgcn_sched_barrier(0);
#pragma unroll
        for (int t = 0; t < 8; ++t) *(LAS f32x4*)(BUl + fr * 132 + 16 * t + 4 * g) = bu[t];
        LDS_WAIT();
        float br[16], bi[16];
#pragma unroll
        for (int t = 0; t < 16; ++t) { br[t] = BUl[t * 132 + lane]; bi[t] = BUl[t * 132 + 64 + lane]; }
#pragma unroll
        for (int t = 0; t < 16; ++t) {
            const float nr = fmaf(a_re, s_re, fmaf(-a_im, s_im, br[t])), ni = fmaf(a_re, s_im, fmaf(a_im, s_re, bi[t]));
            s_re = nr; s_im = ni;
            if (FULL) { const unsigned w = cvt_pk_bf16(nr, ni); Sl[t * 136 + lane] = (bf16_t)(w & 0xffffu); Sl[t * 136 + 64 + lane] = (bf16_t)(w >> 16); }
        }
        if (FULL) {
            LDS_WAIT();
            f32x4 y = (f32x4){0.f, 0.f, 0.f, 0.f};
#pragma unroll
            for (int kk = 0; kk < 4; ++kk) { const bf16x8 sf = *(const LAS bf16x8*)(wl + 8448 + (fr * 136 + 32 * kk + 8 * g) * 2);
                y = __builtin_amdgcn_mfma_f32_16x16x32_bf16(sf, cmf[kk], y, 0, 0, 0); }
            __builtin_amdgcn_sched_barrier(0); asm volatile("s_nop 15\n\ts_nop 15" ::: "memory"); __builtin_amdgcn_sched_barrier(0);
#pragma unroll
            for (int j = 0; j < 4; ++j) { const size_t tok = t0 + 4 * g + j; const float uu = bf2f(upre[j]);
                const float yy = gelu_tanh(y[j] + dval * uu); YS[tok * 1024 + gi * 16 + fr] = (bf16_t)(cvt_pk_bf16(yy, 0.f) & 0xffffu); }
        }
        LDS_WAIT();
    }
}

#define XB_TMO      128
#define XB_XCNT(j)  (256  + 64 * (j))
#define XB_XSUB(j)  (1280 + 64 * (j))
#define XB_XGEN(j)  (2304 + 64 * (j))
#define XB_TOP      3328
#define XB_TOPGEN   3392
#define XCD_BAR_WORDS 3456
#define XB_SPIN_CAP (1u << 18)

__device__ __forceinline__ unsigned xb_ld(unsigned* p)              { return __hip_atomic_load(p, __ATOMIC_RELAXED, __HIP_MEMORY_SCOPE_AGENT); }
__device__ __forceinline__ unsigned xb_add(unsigned* p, unsigned v) { return __hip_atomic_fetch_add(p, v, __ATOMIC_RELAXED, __HIP_MEMORY_SCOPE_AGENT); }
__device__ __forceinline__ unsigned xb_xcc_id() { return (unsigned)__builtin_amdgcn_s_getreg((3 << 11) | 20) & 0xFu; }
#define XB_SPIN(cond, bar) do { unsigned _sp = 0; while (cond) { __builtin_amdgcn_s_sleep(1); \
    if ((++_sp & 255u) == 0u) { if (xb_ld(&(bar)[XB_TMO])) break; if (_sp > XB_SPIN_CAP) { atomicAdd(&(bar)[XB_TMO], 1u); break; } } } } while (0)

struct XcdBarrier {
    unsigned* bar; unsigned x;
    volatile LAS unsigned* st;
};

__device__ __forceinline__ XcdBarrier xcd_barrier_post(unsigned* bar, volatile LAS unsigned* st) {
    XcdBarrier b; b.bar = bar; b.x = xb_xcc_id(); b.st = st;
    if (threadIdx.x == 0) (void)xb_add(&bar[XB_XCNT(b.x)], 1u);
    return b;
}
__device__ __forceinline__ void xcd_barrier_complete(unsigned* bar, unsigned x, unsigned& nloc, unsigned& nx) {
    const unsigned G = gridDim.x * gridDim.y * gridDim.z;
    unsigned sum, cnt, mine, sp = 0u;
    for (;;) {
        sum = 0u; cnt = 0u; mine = 0u;
#pragma unroll
        for (unsigned j = 0; j < 16; ++j) { const unsigned c = xb_ld(&bar[XB_XCNT(j)]); sum += c; cnt += (c > 0u) ? 1u : 0u; mine = (j == x) ? c : mine; }
        if (sum == G) break;
        __builtin_amdgcn_s_sleep(1);
        if ((++sp & 255u) == 0u) { if (xb_ld(&bar[XB_TMO])) break; if (sp > XB_SPIN_CAP) { atomicAdd(&bar[XB_TMO], 1u); break; } }
    }
    nloc = mine > 0u ? mine : 1u; nx = cnt > 0u ? cnt : 1u;
}

__device__ __forceinline__ void xcd_barrier(const XcdBarrier& b) {
    asm volatile("s_waitcnt vmcnt(0)" ::: "memory");
    __syncthreads();
    if (threadIdx.x == 0) {
        unsigned* bar = b.bar;
        __builtin_amdgcn_s_waitcnt(0);
        unsigned nloc = b.st[0], nx = b.st[1];
        if (nloc == 0u) { xcd_barrier_complete(bar, b.x, nloc, nx); b.st[0] = nloc; b.st[1] = nx; }
        const unsigned old = xb_add(&bar[XB_XSUB(b.x)], 1u);
        const unsigned gen = old / nloc;
        if (old + 1u == (gen + 1u) * nloc) {
            __builtin_amdgcn_fence(__ATOMIC_RELEASE, "agent");
            asm volatile("s_waitcnt vmcnt(0)" ::: "memory");
            const unsigned og = xb_add(&bar[XB_TOP], 1u);
            const unsigned tg = og / nx;
            if (og + 1u == (tg + 1u) * nx) xb_add(&bar[XB_TOPGEN], 1u);
            else XB_SPIN(xb_ld(&bar[XB_TOPGEN]) == tg, bar);
            __builtin_amdgcn_fence(__ATOMIC_ACQUIRE, "agent");
            xb_add(&bar[XB_XGEN(b.x)], 1u);
            asm volatile("s_waitcnt vmcnt(0)" ::: "memory");
        } else {
            XB_SPIN(xb_ld(&bar[XB_XGEN(b.x)]) == gen, bar);
            __builtin_amdgcn_fence(__ATOMIC_ACQUIRE, "agent");
            asm volatile("s_waitcnt vmcnt(0)" ::: "memory");
        }
    }
    __syncthreads();
}


__global__ void __launch_bounds__(512, 2) mega_fwd(Params p) {
    extern __shared__ __attribute__((aligned(16))) unsigned char lds_raw[];
    cg::grid_group grid = cg::this_grid();
    LAS unsigned char* lds = (LAS unsigned char*)lds_raw;
    const int wave = __builtin_amdgcn_readfirstlane(threadIdx.x >> 6);
    const int G = gridDim.x, gw = blockIdx.x * 8 + wave, NGW = G * 8;
    LAS unsigned char* wl = lds + wave * WLDS;
    unsigned char* ws = p.ws;
    bf16_t* U = (bf16_t*)(ws + WS_U); bf16_t* BIG = (bf16_t*)(ws + WS_BIG); bf16_t* YO = (bf16_t*)(ws + WS_YO); float* RSQ = (float*)(ws + WS_RSQ);
    bf16_t* OS = YO; bf16_t* OA = YO + (size_t)M * 1024; bf16_t* OM = YO + (size_t)2 * M * 1024; bf16_t* YS = (bf16_t*)(ws + WS_YS);
    volatile LAS unsigned* bst = (volatile LAS unsigned*)(lds + 131072 + 64);
    if (threadIdx.x < 2) bst[threadIdx.x] = 0u;
    __syncthreads();
    const XcdBarrier xbar = xcd_barrier_post((unsigned*)ws, bst);
    const int lo = p.ph_lo, hi = p.ph_hi;
#define IN(k) (lo <= (k) && (k) < hi)
#define GSYNC() do { asm volatile("s_waitcnt vmcnt(0) lgkmcnt(0)" ::: "memory"); grid.sync(); __builtin_amdgcn_fence(__ATOMIC_ACQUIRE, "agent"); asm volatile("s_waitcnt vmcnt(0)" ::: "memory"); } while (0)
#define XSYNC() do { xcd_barrier(xbar); } while (0)
#define SEAM(k) do { if (IN(k) && IN((k) + 1)) { if ((k) == 0) GSYNC(); else XSYNC(); } } while (0)

    if (IN(0)) {
        const int lane = lane_id();
        LAS float* scr = (LAS float*)wl;
        struct TJ { int idx, K, N; size_t dst; int roff, inter; };
        const TJ jobs[15] = {
            {I_F1G, D, FF, WS_WGU1, 0, 1}, {I_F1U, D, FF, WS_WGU1, 128, 1}, {I_F1D, FF, D, WS_WD1, 0, 0}, {I_WIN, D, 11264, WS_WIN, 0, 0},
            {I_SWGLU, 1024, 1024, WS_WGLU, 0, 0}, {I_WMK, D, 1024, WS_WMKV, 0, 0}, {I_WMV, D, 1024, WS_WMKV, 1024, 0},
            {I_WBS, 1024, D, WS_WBR, 0, 0}, {I_WBA, 1024, D, WS_WBR + (size_t)2048 * 1024 * 2, 0, 0}, {I_WBM, 1024, D, WS_WBR + (size_t)2 * 2048 * 1024 * 2, 0, 0},
            {I_WOUT, D, D, WS_WOUT, 0, 0}, {I_F2G, D, FF, WS_WGU2, 0, 1}, {I_F2U, D, FF, WS_WGU2, 128, 1}, {I_F2D, FF, D, WS_WD2, 0, 0}, {0, 0, 0, 0, 0, 0}};
        int base = 0;
#pragma unroll
        for (int j = 0; j < 14; ++j) {
            const int K = jobs[j].K, N = jobs[j].N, ni = (K / 64) * (N / 32);
            int first = (gw - (base % NGW)); if (first < 0) first += NGW;
            for (int it = first; it < ni; it += NGW) tr_item(p.in[jobs[j].idx], K, N, (bf16_t*)(ws + jobs[j].dst), jobs[j].roff, jobs[j].inter, scr, it, lane);
            base += ni;
        }
        for (int row = gw; row < M; row += NGW)
            rms_row_to_bf16(row < MP ? p.in[I_XP] + (size_t)row * D : p.in[I_XS] + (size_t)(row - MP) * D, p.in[I_F1PRE], U + (size_t)row * D, lane);
        for (int row = gw; row < 2048; row += NGW) rms_row_to_bf16(p.in[I_MEMP] + (size_t)row * D, p.in[I_MEMNORM], (bf16_t*)(ws + WS_MN) + (size_t)row * D, lane);
        cvt_copy(p.in[I_CAK], (bf16_t*)(ws + WS_CK), (size_t)16 * 512 * 1024, gw, NGW, lane);
        cvt_copy(p.in[I_CAV], (bf16_t*)(ws + WS_CV), (size_t)16 * 512 * 1024, gw, NGW, lane);
        cvt_copy(p.in[I_CMK], (bf16_t*)(ws + WS_CMK), (size_t)16 * 256 * 1024, gw, NGW, lane);
        mvt_build<float>(p.in[I_CMV], 1024, 0, (bf16_t*)(ws + WS_CMVT), 16, (size_t)gw * 64 + lane, (size_t)NGW * 64);
        {
            const int idx = (NGW - 1 - gw) * 64 + lane;
            if (idx < 4096) {
                const int gi = idx >> 6, pp = idx & 63;
                const double are = (double)p.in[I_SARE][idx], aim = (double)p.in[I_SAIM][idx], dt = exp((double)p.in[I_SLDT][gi]);
                const double mag = exp(are * dt), abr = mag * cos(aim * dt), abi = mag * sin(aim * dt);
                const double magL = exp(are * dt * (double)SEG), alr = magL * cos(aim * dt * (double)SEG), ali = magL * sin(aim * dt * (double)SEG);
                const double den = are * are + aim * aim, nr = abr - 1.0, ni = abi;
                const double cr = (nr * are + ni * aim) / den, ci = (ni * are - nr * aim) / den;
                float* SAB = (float*)(ws + WS_SAB); bf16_t* SBB = (bf16_t*)(ws + WS_SBB); bf16_t* SCM = (bf16_t*)(ws + WS_SCM);
                *(f32x4*)(SAB + (size_t)idx * 4) = (f32x4){(float)abr, (float)abi, (float)alr, (float)ali};
#pragma unroll
                for (int h = 0; h < 16; h += 2) {
                    const double br0 = p.in[I_SBRE][(size_t)idx * 16 + h], bi0 = p.in[I_SBIM][(size_t)idx * 16 + h], br1 = p.in[I_SBRE][(size_t)idx * 16 + h + 1], bi1 = p.in[I_SBIM][(size_t)idx * 16 + h + 1];
                    *(unsigned*)(SBB + (size_t)(gi * 128 + pp) * 16 + h) = cvt_pk_bf16((float)(cr * br0 - ci * bi0), (float)(cr * br1 - ci * bi1));
                    *(unsigned*)(SBB + (size_t)(gi * 128 + 64 + pp) * 16 + h) = cvt_pk_bf16((float)(cr * bi0 + ci * br0), (float)(cr * bi1 + ci * br1));
                }
#pragma unroll
                for (int h = 0; h < 16; ++h) {
                    SCM[(size_t)(gi * 16 + h) * 128 + pp] = (bf16_t)(cvt_pk_bf16(p.in[I_SCRE][(size_t)(gi * 16 + h) * 64 + pp], 0.f) & 0xffffu);
                    SCM[(size_t)(gi * 16 + h) * 128 + 64 + pp] = (bf16_t)(cvt_pk_bf16(-p.in[I_SCIM][(size_t)(gi * 16 + h) * 64 + pp], 0.f) & 0xffffu);
                }
            }
        }
    }
    SEAM(0);
    if (IN(1)) {
        { pg8::Gemm g{U, (const bf16_t*)(ws + WS_WGU1), D, 0, 0}; pg8::Sched S; S.init(M, 2 * FF, G, blockIdx.x, 1); pg8::EpiSwiglu E{BIG}; pg8::gemm_phase(lds, g, S, E, wave); }
        { pg8::Gemm g{(const bf16_t*)(ws + WS_MN), (const bf16_t*)(ws + WS_WMKV), D, 0, 0}; pg8::Sched S; S.init(2048, 2048, G, (blockIdx.x + G - 44) % G, 1); pg8::EpiMemKV E{(bf16_t*)(ws + WS_MKV), p.out}; pg8::gemm_phase(lds, g, S, E, wave); }
    }
    SEAM(1);
    if (IN(2)) {
        { pg8::Gemm g{BIG, (const bf16_t*)(ws + WS_WD1), FF, 0, 0}; pg8::Sched S; S.init(MP, D, G, blockIdx.x, 1); pg8::EpiDown E{YO, RSQ}; pg8::gemm_phase(lds, g, S, E, wave); }
        { pg8::Gemm g{BIG + (size_t)MP * FF, (const bf16_t*)(ws + WS_WD1), 512, 1024, 1024, FF}; pg8::SchedSplit S{8, 11, G, (int)blockIdx.x}; pg8::EpiSplitAcc E{(float*)(ws + WS_ZS)}; pg8::gemm_phase(lds, g, S, E, wave); }
    }
    SEAM(2);
    if (IN(3)) { mvt_build<bf16_t>((const bf16_t*)(ws + WS_MKV), 2048, 1024, (bf16_t*)(ws + WS_MVT), 8, (size_t)gw * 64 + lane_id(), (size_t)NGW * 64);
        ew_phase<1>(p, p.in[I_F1POST], p.in[I_MIXPRE], gw, NGW, lane_id(), 11); }
    SEAM(3);
    if (IN(4)) { pg8::Gemm g{U, (const bf16_t*)(ws + WS_WIN), D, 0, 0}; pg8::Sched S; S.init(M, NIN5, G, blockIdx.x, 1); pg8::EpiWin E{BIG, p.out}; pg8::gemm_phase(lds, g, S, E, wave); }
    SEAM(4);
    if (IN(5)) {
        const bf16_t* PROJ = BIG;
        constexpr int N_SA = 8 * 64 * (NSEG - 1), N_BP = 8 * 64 * 16, N_MP = 8 * 256 * 4, N_BS = 256, N_MSs = 64;
        {
            const int lane = lane_id();
            const bool xmap = (G % 8 == 0);
            const int wxs = xmap ? (G / 8) * 8 : NGW, wx0 = xmap ? (int)(blockIdx.x >> 3) * 8 + wave : gw;
            for (int r0 = wx0; r0 < (xmap ? 1024 : N_BP); r0 += wxs) {
                const int r = xmap ? ((int)(blockIdx.x & 7) << 10) + r0 : r0;
                const int h = r & 15, c = (r >> 4) & 63, b = r >> 10;
                const int c0 = c >= 8 ? c - 8 : 0; const size_t qrow = (size_t)b * TP + c * 64, krow = (size_t)b * TP + c0 * 64;
                attn_item<4, 64, true, false>(PROJ + qrow * NIN5 + 1024 + h * 64, NIN5, PROJ + krow * NIN5 + 2048 + h * 64, PROJ + krow * NIN5 + 3072 + h * 64, (size_t)64 * NIN5, NIN5, c - c0 + 1,
                                       nullptr, nullptr, 0, 0, false, c * 64, c0 * 64, 0.125f, p.in[I_RELB] + h * 257, OA + qrow * 1024 + h * 64, 1024, wl, lane);
            }
        }
        {
            const int lane = lane_id();
            for (int r = (gw + NGW - 512) % NGW; r < N_SA; r += NGW) {
                const int gi = r & 63, rest = r >> 6, seg = rest % (NSEG - 1), b = rest / (NSEG - 1), bg = b * 64 + gi;
                float s_re = 0.f, s_im = 0.f;
                ssm_run<false>(p, gi, (size_t)b * TP + seg * SEG, SEG / 16, s_re, s_im, wl, lane);
                float* SE = (float*)(ws + WS_SE) + ((size_t)bg * NSEG + seg) * 128; SE[lane] = s_re; SE[64 + lane] = s_im;
            }
        }
        {
            const int lane = lane_id();
            const bool xmap = (G % 8 == 0);
            const int wxs = xmap ? (G / 8) * 8 : NGW, wx0 = xmap ? (int)(blockIdx.x >> 3) * 8 + wave : gw;
            for (int r0 = wx0; r0 < (xmap ? 1024 : N_MP); r0 += wxs) {
                const int r = xmap ? ((int)(blockIdx.x & 7) << 10) + r0 : r0;
                const int h = r & 3, qb = (r >> 2) & 255, b = r >> 10;
                const size_t qrow = (size_t)b * TP + qb * 16; const bf16_t* MKV = (const bf16_t*)(ws + WS_MKV) + (size_t)b * 256 * 2048 + h * 256;
                attn_item<1, 256, false, true>(PROJ + qrow * NIN5 + 4096 + h * 256, NIN5, MKV, MKV + 1024, (size_t)64 * 2048, 2048, 4,
                                         nullptr, nullptr, 0, 0, false, 0, 0, 0.0625f, nullptr, OM + qrow * 1024 + h * 256, 1024, wl, lane, (const bf16_t*)(ws + WS_MVT) + (size_t)(b * 4 + h) * 65536);
            }
        }
        {
            const int lane = lane_id();
            for (int r = (gw + NGW - 1536) % NGW; r < N_BS; r += NGW) {
                const int h = r & 15, b = r >> 4; const size_t qrow = (size_t)MP + b * 16;
                const bf16_t* CK = (const bf16_t*)(ws + WS_CK) + (size_t)b * 512 * 1024 + h * 64; const bf16_t* CV = (const bf16_t*)(ws + WS_CV) + (size_t)b * 512 * 1024 + h * 64;
                attn_item<1, 64, true, false>(PROJ + qrow * NIN5 + 1024 + h * 64, NIN5, CK, CV, (size_t)64 * 1024, 1024, 8,
                                       PROJ + qrow * NIN5 + 2048 + h * 64, PROJ + qrow * NIN5 + 3072 + h * 64, NIN5, 16, true, 4096, 3584, 0.125f, p.in[I_RELB] + h * 257,
                                       OA + qrow * 1024 + h * 64, 1024, wl, lane);
            }
        }
        {
            const int lane = lane_id();
            for (int r = (gw + NGW - 1800) % NGW; r < N_MSs; r += NGW) {
                const int h = r & 3, b = r >> 2; const size_t qrow = (size_t)MP + b * 16;
                const bf16_t* CMK = (const bf16_t*)(ws + WS_CMK) + (size_t)b * 256 * 1024 + h * 256; const bf16_t* CMV = (const bf16_t*)(ws + WS_CMV) + (size_t)b * 256 * 1024 + h * 256;
                attn_item<1, 256, false, true>(PROJ + qrow * NIN5 + 4096 + h * 256, NIN5, CMK, CMV, (size_t)64 * 1024, 1024, 4,
                                         nullptr, nullptr, 0, 0, false, 0, 0, 0.0625f, nullptr, OM + qrow * 1024 + h * 256, 1024, wl, lane, (const bf16_t*)(ws + WS_CMVT) + (size_t)(b * 4 + h) * 65536);
            }
        }
    }
    SEAM(5);
    if (IN(6)) {
        const int lane = lane_id();
        constexpr int N_SB = 8 * 64 * NSEG, N_SS = 16 * 64;
        const float* SAB = (const float*)(ws + WS_SAB);
        for (int it = gw; it < N_SB + N_SS; it += NGW) {
            if (it < N_SB) {
                const int gi = it & 63, seg = (it >> 6) & (NSEG - 1), b = it >> 10, bg = b * 64 + gi;
                const f32x4 ab = *(const f32x4*)(SAB + (size_t)(gi * 64 + lane) * 4);
                float s_re = 0.f, s_im = 0.f; const float* SE = (const float*)(ws + WS_SE) + (size_t)bg * NSEG * 128;
                for (int i = 0; i < seg; ++i) { const float er = SE[i * 128 + lane], ei = SE[i * 128 + 64 + lane];
                    const float nr = fmaf(ab[2], s_re, fmaf(-ab[3], s_im, er)), ni = fmaf(ab[2], s_im, fmaf(ab[3], s_re, ei)); s_re = nr; s_im = ni; }
                ssm_run<true>(p, gi, (size_t)b * TP + seg * SEG, SEG / 16, s_re, s_im, wl, lane);
                if (seg == NSEG - 1) { p.out[O_SRE_P + (size_t)bg * 64 + lane] = s_re; p.out[O_SIM_P + (size_t)bg * 64 + lane] = s_im; }
            } else {
                const int bg = it - N_SB, gi = bg & 63, b = bg >> 6;
                float s_re = p.in[I_SRE][(size_t)bg * 64 + lane], s_im = p.in[I_SIM][(size_t)bg * 64 + lane];
                ssm_run<true>(p, gi, (size_t)MP + b * 16, 1, s_re, s_im, wl, lane);
                p.out[O_SRE_S + (size_t)bg * 64 + lane] = s_re; p.out[O_SIM_S + (size_t)bg * 64 + lane] = s_im;
            }
        }
    }
    SEAM(6);
    if (IN(7)) {
        { pg8::Gemm g{YS, (const bf16_t*)(ws + WS_WGLU), 1024, 0, 0}; pg8::Sched S; S.init(M, 1024, G, blockIdx.x, 1); pg8::EpiGlu E{YS, p.in[I_SBGLU], OS}; pg8::gemm_phase(lds, g, S, E, wave); }
        { pg8::Gemm g{U, (const bf16_t*)(ws + WS_WIN) + (size_t)NIN5 * D, D, 0, 0}; pg8::Sched S; S.init(M, NGATE, G, (blockIdx.x + G - 4) % G, 1); pg8::EpiGate E{BIG};
        pg8::gemm_phase(lds, g, S, E, wave); }
    }
    SEAM(7);
    if (IN(8)) {
        pg8::Gemm g{OS, (const bf16_t*)(ws + WS_WBR), 1024, (size_t)M * 1024 * 2, (size_t)2048 * 1024 * 2}; pg8::Sched S; S.init(M, D, G, blockIdx.x, 3); pg8::EpiBranch E{BIG, U}; pg8::gemm_phase(lds, g, S, E, wave); }
    SEAM(8);
    if (IN(9)) {
        { pg8::Gemm g{U, (const bf16_t*)(ws + WS_WOUT), D, 0, 0}; pg8::Sched S; S.init(MP, D, G, blockIdx.x, 1); pg8::EpiDown E{YO, RSQ}; pg8::gemm_phase(lds, g, S, E, wave); }
        { pg8::Gemm g{U + (size_t)MP * D, (const bf16_t*)(ws + WS_WOUT), 512, 1024, 1024, D}; pg8::SchedSplit S{8, 4, G, (int)blockIdx.x}; pg8::EpiSplitAcc E{(float*)(ws + WS_ZS)}; pg8::gemm_phase(lds, g, S, E, wave); }
    }
    SEAM(9);
    if (IN(10)) ew_phase<2>(p, p.in[I_MIXPOST], p.in[I_F2PRE], gw, NGW, lane_id(), 4);
    SEAM(10);
    if (IN(11)) {
        pg8::Gemm g{U, (const bf16_t*)(ws + WS_WGU2), D, 0, 0}; pg8::Sched S; S.init(M, 2 * FF, G, blockIdx.x, 1); pg8::EpiSwiglu E{BIG}; pg8::gemm_phase(lds, g, S, E, wave); }
    SEAM(11);
    if (IN(12)) {
        { pg8::Gemm g{BIG, (const bf16_t*)(ws + WS_WD2), FF, 0, 0}; pg8::Sched S; S.init(MP, D, G, blockIdx.x, 1); pg8::EpiDown E{YO, RSQ}; pg8::gemm_phase(lds, g, S, E, wave); }
        { pg8::Gemm g{BIG + (size_t)MP * FF, (const bf16_t*)(ws + WS_WD2), 512, 1024, 1024, FF}; pg8::SchedSplit S{8, 11, G, (int)blockIdx.x}; pg8::EpiSplitAcc E{(float*)(ws + WS_ZS)}; pg8::gemm_phase(lds, g, S, E, wave); }
    }
    SEAM(12);
    if (IN(13)) ew_phase<3>(p, p.in[I_F2POST], nullptr, gw, NGW, lane_id(), 11);
#undef IN
#undef SEAM
}

extern "C" void kernel_launch(void* const* d_in, const int* in_sizes, int n_in, void* d_out, int out_size, void* d_ws, size_t ws_size, hipStream_t stream) {
    static int grid = 0;
    if (grid == 0) {
        if (n_in != 40 || ws_size < WS_END) { fprintf(stderr, "kernel_launch: unexpected n_in %d / ws %zu\n", n_in, ws_size); grid = -1; return; }
        int dev = 0, cus = 0, per_cu = 0;
        hipGetDevice(&dev); hipDeviceGetAttribute(&cus, hipDeviceAttributeMultiprocessorCount, dev);
        if (hipFuncSetAttribute((const void*)mega_fwd, hipFuncAttributeMaxDynamicSharedMemorySize, LDS_BYTES) != hipSuccess) { fprintf(stderr, "kernel_launch: hipFuncSetAttribute failed\n"); grid = -1; return; }
        if (hipOccupancyMaxActiveBlocksPerMultiprocessor(&per_cu, (const void*)mega_fwd, 512, LDS_BYTES) != hipSuccess || per_cu < 1) { fprintf(stderr, "kernel_launch: occupancy query says %d\n", per_cu); per_cu = 1; }
        (void)hipGetLastError();
        grid = cus * per_cu;
    }
    if (grid < 0) return;
    if (hipMemsetAsync(d_ws, 0, 16384, stream) != hipSuccess) { fprintf(stderr, "kernel_launch: memset of barrier words failed\n"); return; }
    Params p{};
    for (int i = 0; i < 40; ++i) p.in[i] = (const float*)d_in[i];
    p.out = (float*)d_out; p.ws = (unsigned char*)d_ws; p.ph_lo = 0; p.ph_hi = 14;
    void* args[] = {&p};
    hipError_t e = hipLaunchCooperativeKernel((const void*)mega_fwd, dim3(grid), dim3(512), args, LDS_BYTES, stream);
    if (e != hipSuccess) fprintf(stderr, "cooperative launch failed: %s (grid %d)\n", hipGetErrorString(e), grid);
}
```

```cpp
#include <hip/hip_runtime.h>
#include <hip/hip_cooperative_groups.h>
#include <cstdio>
#include <cstdint>
namespace cg = cooperative_groups;

#define LAS __attribute__((address_space(3)))
typedef unsigned short bf16_t;
typedef short bf16x8 __attribute__((ext_vector_type(8)));
typedef short bf16x4 __attribute__((ext_vector_type(4)));
typedef float f32x4 __attribute__((ext_vector_type(4)));
typedef unsigned u32x4 __attribute__((ext_vector_type(4)));
typedef unsigned u32x2 __attribute__((ext_vector_type(2)));

constexpr int D = 2048, MP = 32768, MS = 256, M = MP + MS, FF = 5632, NIN5 = 5120, NGATE = 6144, TP = 4096;
constexpr float EPS = 1e-6f;
constexpr int SEG = 256, NSEG = TP / SEG;
constexpr size_t O_Y = 0;
constexpr size_t O_ATTK_P = (size_t)M * D;
constexpr size_t O_ATTV_P = O_ATTK_P + 4194304;
constexpr size_t O_MEMK_P = O_ATTV_P + 4194304;
constexpr size_t O_MEMV_P = O_MEMK_P + 2097152;
constexpr size_t O_SRE_P = O_MEMV_P + 2097152;
constexpr size_t O_SIM_P = O_SRE_P + 32768;
constexpr size_t O_ATTK_S = O_SIM_P + 32768;
constexpr size_t O_ATTV_S = O_ATTK_S + 262144;
constexpr size_t O_SRE_S = O_ATTV_S + 262144;
constexpr size_t O_SIM_S = O_SRE_S + 65536;
constexpr size_t MiB = 1u << 20;
constexpr size_t WS_WGU1 = 1 * MiB, WS_WD1 = 45 * MiB, WS_WIN = 67 * MiB, WS_WGLU = 111 * MiB, WS_WMKV = 113 * MiB, WS_WBR = 121 * MiB,
                 WS_WOUT = 133 * MiB, WS_WGU2 = 141 * MiB, WS_WD2 = 185 * MiB;
constexpr size_t WS_YS = 1 * MiB;
constexpr size_t WS_U = 207 * MiB;
constexpr size_t WS_BIG = 336 * MiB;
constexpr size_t WS_YO = 723 * MiB;
constexpr size_t WS_MN = 917 * MiB, WS_MKV = 925 * MiB, WS_CK = 933 * MiB, WS_CV = 949 * MiB, WS_CMK = 965 * MiB, WS_CMV = 973 * MiB;
constexpr size_t WS_RSQ = 981 * MiB;
constexpr size_t WS_SE = 986 * MiB;
constexpr size_t WS_SAB = 990 * MiB;
constexpr size_t WS_SBB = 990 * MiB + 65536;
constexpr size_t WS_SCM = 990 * MiB + 65536 + 262144;
constexpr size_t WS_MVT = 992 * MiB;
constexpr size_t WS_CMVT = 996 * MiB;
constexpr size_t WS_ZS = 691 * MiB;
constexpr size_t WS_END = 1004 * MiB;
constexpr int LDS_BYTES = 147456;
constexpr int WLDS = 16384;

__device__ __forceinline__ unsigned cvt_pk_bf16(float lo, float hi) { unsigned r; asm volatile("s_nop 1\n\tv_cvt_pk_bf16_f32 %0, %1, %2\n\ts_nop 0" : "=v"(r) : "v"(lo), "v"(hi)); return r; }
__device__ __forceinline__ float bf2f(unsigned b) { return __uint_as_float(b << 16); }
__device__ __forceinline__ float bflo(unsigned w) { return __uint_as_float(w << 16); }
__device__ __forceinline__ float bfhi(unsigned w) { return __uint_as_float(w & 0xffff0000u); }
__device__ __forceinline__ float wave_sum(float v) {
#pragma unroll
    for (int o = 1; o < 64; o <<= 1) v += __shfl_xor(v, o);
    return v;
}
__device__ __forceinline__ float sigmoidf_(float x) { return __builtin_amdgcn_rcpf(1.0f + __expf(-x)); }
#define LDS_WAIT() asm volatile("s_waitcnt lgkmcnt(0)" ::: "memory")
__device__ __forceinline__ int lane_id() { int l; asm volatile("v_mbcnt_lo_u32_b32 %0, -1, 0\n\tv_mbcnt_hi_u32_b32 %0, -1, %0" : "=v"(l)); return l; }

namespace pg8 {
constexpr int BM = 256, BK = 64, HALF = 128, HTB = HALF * BK * 2, STAGE_BYTES = 8 * HTB, NXCD = 8, WGM = 8;
__host__ __device__ __forceinline__ int lds_byte(int r, int c) { const int st = (r >> 4) * 2 + (c >> 5), rr = r & 15, cc = c & 31, ob = rr * 64 + cc * 2; return st * 1024 + (ob ^ (((ob >> 9) & 1) << 5)); }
__host__ __device__ __forceinline__ void stage_rc(int b, int& R, int& C) { const int st = b / 1024, sb = b % 1024, swz = sb ^ (((sb >> 9) & 1) << 5); R = (st >> 1) * 16 + swz / 64; C = (st & 1) * 32 + (swz % 64) / 2; }
__host__ __device__ __forceinline__ int perm32(int rho) { const int n = rho >> 4, i = rho & 15; return 8 * (i >> 2) + 4 * n + (i & 3); }

struct Unit { int pm, pn, z; };
struct Gemm { const bf16_t* A; const bf16_t* Bt; int K; size_t zsA, zsB; int ld; };

struct Sched {
    int nM, nN, nwg, G, c, Z;
    __device__ void init(int M_, int N_, int G_, int c_, int Z_) { nM = M_ / BM; nN = N_ / BM; nwg = nM * nN; G = G_; c = c_; Z = Z_; }
    __device__ bool next(int i, Unit& u) const {
        int z = 0, ii = i;
        if (Z > 1) { z = i % Z; ii = i / Z; }
        const long L = (long)ii * G + c; if (L >= nwg) return false;
        int wgid = (int)L; { const int q = nwg / NXCD, r = nwg % NXCD, xcd = wgid % NXCD, off = wgid / NXCD; wgid = (xcd < r ? xcd * (q + 1) : r * (q + 1) + (xcd - r) * q) + off; }
        const int nig = WGM * nN, gid = wgid / nig, fm = gid * WGM, gsz = (nM - fm) < WGM ? (nM - fm) : WGM;
        u.pm = fm + ((wgid % nig) % gsz); u.pn = (wgid % nig) / gsz; u.z = z; return true;
    }
};

template <class Epi, class SchedT>
__device__ __forceinline__ void gemm_phase(LAS unsigned char* lds, const Gemm g, const SchedT& S, const Epi& E, const int wid) {
    const int lane = lane_id(), tid = wid * 64 + lane, wr = wid >> 2, wc = wid & 3, fr = lane & 15, fq = lane >> 4;
    const int K = g.K, nt = K / BK, ld = g.ld ? g.ld : g.K;
    unsigned voffA[2], voffB[2];
#pragma unroll
    for (int i = 0; i < 2; ++i) { int R, C; stage_rc(tid * 16 + i * 8192, R, C); const int Rb = (R & ~31) + perm32(R & 31);
        voffA[i] = (unsigned)(R * ld + C) * 2u; voffB[i] = (unsigned)(Rb * ld + C) * 2u; }
    const size_t kstep = (size_t)(BK * 2);
    const size_t hstep = (size_t)HALF * ld * 2;
    const size_t tstep = 2 * hstep;
    const unsigned ldsw = (unsigned)wid * 1024u;
    const int aoff = lds_byte(wr * 64 + fr, fq * 8), boff = lds_byte(wc * 32 + fr, fq * 8);
#define PG8_SA(b, h) (((b) * 2 + (h)) * HTB)
#define PG8_SB(b, h) ((4 + (b) * 2 + (h)) * HTB)
#define PG8_STAGE(bufoff, gbase, voff) do { _Pragma("unroll") for (int _i = 0; _i < 2; ++_i) \
        __builtin_amdgcn_global_load_lds((const unsigned*)((const char*)(gbase) + (voff)[_i]), (LAS unsigned*)(lds + (bufoff) + ldsw + _i * 8192), 16, 0, 0); } while (0)
#define PG8_LDA(dst, b, h) do { _Pragma("unroll") for (int m = 0; m < 4; ++m) _Pragma("unroll") for (int k = 0; k < 2; ++k) dst[m][k] = *(const LAS bf16x8*)(lds + PG8_SA(b, h) + aoff + m * 2048 + k * 1024); } while (0)
#define PG8_LDB(dst, b, h) do { _Pragma("unroll") for (int n = 0; n < 2; ++n) _Pragma("unroll") for (int k = 0; k < 2; ++k) dst[n][k] = *(const LAS bf16x8*)(lds + PG8_SB(b, h) + boff + n * 2048 + k * 1024); } while (0)
#define PG8_MMA(ai, bj, At, Bt) do { __builtin_amdgcn_s_setprio(1); _Pragma("unroll") for (int m = 0; m < 4; ++m) _Pragma("unroll") for (int n = 0; n < 2; ++n) _Pragma("unroll") for (int k = 0; k < 2; ++k) \
        acc[ai][bj][m][n] = __builtin_amdgcn_mfma_f32_16x16x32_bf16(Bt[n][k], At[m][k], acc[ai][bj][m][n], 0, 0, 0); __builtin_amdgcn_s_setprio(0); } while (0)
#define PG8_WAIT_V(n) asm volatile("s_waitcnt vmcnt(" #n ")" ::: "memory")
#define PG8_WAIT_L(n) asm volatile("s_waitcnt lgkmcnt(" #n ")" ::: "memory")
#define PG8_BAR __builtin_amdgcn_s_barrier()
#define PG8_SCHED __builtin_amdgcn_sched_barrier(0)
    Unit cur, nxt; int ui = 0;
    if (!S.next(0, cur)) return;
    f32x4 acc[2][2][4][2];
#pragma unroll
    for (int a = 0; a < 2; ++a)
#pragma unroll
        for (int b = 0; b < 2; ++b)
#pragma unroll
            for (int m = 0; m < 4; ++m)
#pragma unroll
                for (int n = 0; n < 2; ++n) acc[a][b][m][n] = (f32x4){0.f, 0.f, 0.f, 0.f};
    bf16x8 At[4][2], B0[2][2], B1[2][2];
    const char* cA = (const char*)g.A + (size_t)cur.z * g.zsA + (size_t)cur.pm * tstep; const char* cB = (const char*)g.Bt + (size_t)cur.z * g.zsB + (size_t)cur.pn * tstep;
    PG8_STAGE(PG8_SB(0, 0), cB, voffB); PG8_STAGE(PG8_SB(0, 1), cB + hstep, voffB); PG8_STAGE(PG8_SA(0, 0), cA, voffA); PG8_STAGE(PG8_SA(0, 1), cA + hstep, voffA);
    if (wr == 1) PG8_BAR;
    PG8_WAIT_V(2); PG8_BAR;
    PG8_STAGE(PG8_SB(1, 0), cB + kstep, voffB); PG8_STAGE(PG8_SA(1, 0), cA + kstep, voffA); PG8_STAGE(PG8_SB(1, 1), cB + hstep + kstep, voffB);
    PG8_WAIT_V(6); PG8_BAR;
    for (;;) {
        const bool has_next = S.next(ui + 1, nxt);
        const char* nA = has_next ? (const char*)g.A + (size_t)nxt.z * g.zsA + (size_t)nxt.pm * tstep : cA; const char* nB = has_next ? (const char*)g.Bt + (size_t)nxt.z * g.zsB + (size_t)nxt.pn * tstep : cB;
        for (int t = 0; t < nt; t += 2) {
            const bool last = (t == nt - 2);
            const char* a1 = cA + (size_t)(t + 1) * kstep;
            const char* a2 = last ? nA : cA + (size_t)(t + 2) * kstep; const char* b2 = last ? nB : cB + (size_t)(t + 2) * kstep;
            const char* a3 = a2 + kstep; const char* b3 = b2 + kstep;
            PG8_LDB(B0, 0, 0); PG8_LDB(B1, 0, 1); PG8_SCHED; PG8_LDA(At, 0, 0); PG8_STAGE(PG8_SA(1, 1), a1 + hstep, voffA);
            PG8_WAIT_V(8); PG8_WAIT_L(0); PG8_BAR; PG8_MMA(0, 0, At, B0); PG8_MMA(0, 1, At, B1); PG8_BAR; PG8_SCHED;
            PG8_LDA(At, 0, 1); PG8_STAGE(PG8_SB(0, 0), b2, voffB); PG8_STAGE(PG8_SB(0, 1), b2 + hstep, voffB); PG8_STAGE(PG8_SA(0, 0), a2, voffA);
            PG8_WAIT_V(8); PG8_WAIT_L(0); PG8_BAR; PG8_MMA(1, 0, At, B0); PG8_MMA(1, 1, At, B1); PG8_BAR; PG8_SCHED;
            PG8_LDB(B0, 1, 0); PG8_LDB(B1, 1, 1); PG8_SCHED; PG8_LDA(At, 1, 0); PG8_STAGE(PG8_SA(0, 1), a2 + hstep, voffA);
            PG8_WAIT_V(8); PG8_WAIT_L(0); PG8_BAR; PG8_MMA(0, 0, At, B0); PG8_MMA(0, 1, At, B1); PG8_BAR; PG8_SCHED;
            PG8_LDA(At, 1, 1); PG8_STAGE(PG8_SB(1, 0), b3, voffB); PG8_STAGE(PG8_SB(1, 1), b3 + hstep, voffB); PG8_STAGE(PG8_SA(1, 0), a3, voffA);
            PG8_WAIT_V(8); PG8_WAIT_L(0); PG8_BAR; PG8_MMA(1, 0, At, B0); PG8_MMA(1, 1, At, B1); PG8_BAR; PG8_SCHED;
        }
        if (wr == 0) PG8_BAR;
        E(acc, cur, wr, wc, fr, fq);
        if (!has_next) break;
#pragma unroll
        for (int a = 0; a < 2; ++a)
#pragma unroll
            for (int b = 0; b < 2; ++b)
#pragma unroll
                for (int m = 0; m < 4; ++m)
#pragma unroll
                    for (int n = 0; n < 2; ++n) acc[a][b][m][n] = (f32x4){0.f, 0.f, 0.f, 0.f};
        cur = nxt; cA = nA; cB = nB; ++ui;
        if (wr == 1) PG8_BAR;
    }
    PG8_WAIT_V(0);
    PG8_BAR;
#undef PG8_SA
#undef PG8_SB
#undef PG8_STAGE
#undef PG8_LDA
#undef PG8_LDB
#undef PG8_MMA
#undef PG8_WAIT_V
#undef PG8_WAIT_L
#undef PG8_BAR
#undef PG8_SCHED
}

struct SchedSplit {
    int nN, S, G, c;
    __device__ bool next(int i, Unit& u) const { const int L = i * G + c; if (L >= nN * S) return false; u.pm = 0; u.pn = L % nN; u.z = L / nN; return true; }
};
typedef const f32x4 (&AccRef)[2][2][4][2];
__device__ __forceinline__ u32x4 pack8(const f32x4 a, const f32x4 b) { u32x4 w; w.x = cvt_pk_bf16(a[0], a[1]); w.y = cvt_pk_bf16(a[2], a[3]); w.z = cvt_pk_bf16(b[0], b[1]); w.w = cvt_pk_bf16(b[2], b[3]); return w; }

struct EpiSwiglu {
    bf16_t* ACT;
    __device__ __forceinline__ void operator()(AccRef acc, const Unit& u, int wr, int wc, int fr, int fq) const {
        const int row0 = u.pm * BM + wr * 64 + fr, col = u.pn * 128 + wc * 32 + 8 * fq;
#pragma unroll
        for (int ai = 0; ai < 2; ++ai)
#pragma unroll
            for (int m = 0; m < 4; ++m) {
                f32x4 r0, r1;
#pragma unroll
                for (int j = 0; j < 4; ++j) { const float g0 = acc[ai][0][m][0][j], g1 = acc[ai][0][m][1][j];
                    r0[j] = g0 * sigmoidf_(g0) * acc[ai][1][m][0][j]; r1[j] = g1 * sigmoidf_(g1) * acc[ai][1][m][1][j]; }
                *(u32x4*)(ACT + (size_t)(row0 + ai * HALF + m * 16) * FF + col) = pack8(r0, r1);
            }
    }
};
struct EpiDown {
    bf16_t* Y; float* RSQ;
    __device__ __forceinline__ void operator()(AccRef acc, const Unit& u, int wr, int wc, int fr, int fq) const {
        const int row0 = u.pm * BM + wr * 64 + fr, col = u.pn * BM + wc * 32 + 8 * fq;
#pragma unroll
        for (int ai = 0; ai < 2; ++ai)
#pragma unroll
            for (int m = 0; m < 4; ++m) { const int row = row0 + ai * HALF + m * 16; float s = 0.f;
#pragma unroll
                for (int bj = 0; bj < 2; ++bj) { const f32x4 a = acc[ai][bj][m][0], b = acc[ai][bj][m][1];
                    s += (a[0] * a[0] + a[1] * a[1]) + (a[2] * a[2] + a[3] * a[3]) + (b[0] * b[0] + b[1] * b[1]) + (b[2] * b[2] + b[3] * b[3]);
                    *(u32x4*)(Y + (size_t)row * D + col + bj * HALF) = pack8(a, b); }
                s += __shfl_xor(s, 16); s += __shfl_xor(s, 32);
                if (fq == 0) RSQ[(size_t)row * 32 + u.pn * 4 + wc] = s; }
    }
};
struct EpiSplitAcc {
    float* ZS;
    __device__ __forceinline__ void operator()(AccRef acc, const Unit& u, int wr, int wc, int fr, int fq) const {
        const int row0 = wr * 64 + fr, col = u.pn * BM + wc * 32 + 8 * fq;
#pragma unroll
        for (int ai = 0; ai < 2; ++ai)
#pragma unroll
            for (int m = 0; m < 4; ++m) { float* rp = ZS + (size_t)(row0 + ai * HALF + m * 16) * D + col;
#pragma unroll
                for (int bj = 0; bj < 2; ++bj)
#pragma unroll
                    for (int n = 0; n < 2; ++n) *(f32x4*)(rp + (size_t)u.z * 256 * D + bj * HALF + 4 * n) = acc[ai][bj][m][n]; }
    }
};
struct EpiWin {
    bf16_t* PROJ; float* out;
    __device__ __forceinline__ void operator()(AccRef acc, const Unit& u, int wr, int wc, int fr, int fq) const {
        const int row0 = u.pm * BM + wr * 64 + fr, col = u.pn * BM + wc * 32 + 8 * fq;
        const bool kv = (u.pn >= 8 && u.pn < 16), isk = u.pn < 12, samp = (u.pm == 128), tailp = (!samp && (u.pm & 15) >= 14);
        const int kcol0 = col - (isk ? 2048 : 3072);
#pragma unroll
        for (int ai = 0; ai < 2; ++ai)
#pragma unroll
            for (int m = 0; m < 4; ++m) { const int row = row0 + ai * HALF + m * 16;
#pragma unroll
                for (int bj = 0; bj < 2; ++bj) { const f32x4 a = acc[ai][bj][m][0], b = acc[ai][bj][m][1];
                    *(u32x4*)(PROJ + (size_t)row * NIN5 + col + bj * HALF) = pack8(a, b);
                    if (kv && (samp || tailp)) {
                        float* dst;
                        if (samp) dst = out + (isk ? O_ATTK_S : O_ATTV_S) + (size_t)(row - MP) * 1024 + kcol0 + bj * HALF;
                        else { const int bb = row >> 12, t = row & 4095; dst = out + (isk ? O_ATTK_P : O_ATTV_P) + (size_t)(bb * 512 + t - 3584) * 1024 + kcol0 + bj * HALF; }
                        *(f32x4*)dst = a; *(f32x4*)(dst + 4) = b; } } }
    }
};
struct EpiMemKV {
    bf16_t* MKV; float* out;
    __device__ __forceinline__ void operator()(AccRef acc, const Unit& u, int wr, int wc, int fr, int fq) const {
        const int row0 = u.pm * BM + wr * 64 + fr, col = u.pn * BM + wc * 32 + 8 * fq;
        const bool isk = u.pn < 4; float* ob = out + (isk ? O_MEMK_P : O_MEMV_P) + (col - (isk ? 0 : 1024));
#pragma unroll
        for (int ai = 0; ai < 2; ++ai)
#pragma unroll
            for (int m = 0; m < 4; ++m) { const int row = row0 + ai * HALF + m * 16;
#pragma unroll
                for (int bj = 0; bj < 2; ++bj) { const f32x4 a = acc[ai][bj][m][0], b = acc[ai][bj][m][1];
                    *(u32x4*)(MKV + (size_t)row * 2048 + col + bj * HALF) = pack8(a, b);
                    float* dst = ob + (size_t)row * 1024 + bj * HALF; *(f32x4*)dst = a; *(f32x4*)(dst + 4) = b; } }
    }
};
struct EpiGate {
    bf16_t* G;
    __device__ __forceinline__ void operator()(AccRef acc, const Unit& u, int wr, int wc, int fr, int fq) const {
        const int row0 = u.pm * BM + wr * 64 + fr, col = u.pn * BM + wc * 32 + 8 * fq;
#pragma unroll
        for (int ai = 0; ai < 2; ++ai)
#pragma unroll
            for (int m = 0; m < 4; ++m) { const int row = row0 + ai * HALF + m * 16;
#pragma unroll
                for (int bj = 0; bj < 2; ++bj) { const f32x4 a = acc[ai][bj][m][0], b = acc[ai][bj][m][1];
                    *(u32x4*)(G + (size_t)row * NGATE + col + bj * HALF) = pack8(a, b); } }
    }
};
__device__ __forceinline__ void unpack8(const u32x4 w, f32x4& a, f32x4& b) { a[0] = bflo(w.x); a[1] = bfhi(w.x); a[2] = bflo(w.y); a[3] = bfhi(w.y); b[0] = bflo(w.z); b[1] = bfhi(w.z); b[2] = bflo(w.w); b[3] = bfhi(w.w); }
struct EpiGlu {
    const bf16_t* YS; const float* bias; bf16_t* OS;
    __device__ __forceinline__ void operator()(AccRef acc, const Unit& u, int wr, int wc, int fr, int fq) const {
        const int row0 = u.pm * BM + wr * 64 + fr, col = u.pn * BM + wc * 32 + 8 * fq;
#pragma unroll
        for (int ai = 0; ai < 2; ++ai)
#pragma unroll
            for (int m = 0; m < 4; ++m) { const int row = row0 + ai * HALF + m * 16;
#pragma unroll
                for (int bj = 0; bj < 2; ++bj) { f32x4 a = acc[ai][bj][m][0], b = acc[ai][bj][m][1];
                    const size_t off = (size_t)row * 1024 + col + bj * HALF;
                    const f32x4 b0 = *(const f32x4*)(bias + col + bj * HALF), b1 = *(const f32x4*)(bias + col + bj * HALF + 4);
                    f32x4 y0, y1; unpack8(__builtin_nontemporal_load((const u32x4*)(YS + off)), y0, y1);
#pragma unroll
                    for (int j = 0; j < 4; ++j) { a[j] = y0[j] * sigmoidf_(a[j] + b0[j]); b[j] = y1[j] * sigmoidf_(b[j] + b1[j]); }
                    *(u32x4*)(OS + off) = pack8(a, b); } }
    }
};
struct EpiBranch {
    const bf16_t* G; bf16_t* MG;
    __device__ __forceinline__ void operator()(AccRef acc, const Unit& u, int wr, int wc, int fr, int fq) const {
        const int row0 = u.pm * BM + wr * 64 + fr, col = u.pn * BM + wc * 32 + 8 * fq;
#pragma unroll
        for (int ai = 0; ai < 2; ++ai)
#pragma unroll
            for (int m = 0; m < 4; ++m) { const int row = row0 + ai * HALF + m * 16;
#pragma unroll
                for (int bj = 0; bj < 2; ++bj) { f32x4 a = acc[ai][bj][m][0], b = acc[ai][bj][m][1];
                    f32x4 g0, g1; unpack8(__builtin_nontemporal_load((const u32x4*)(G + (size_t)row * NGATE + u.z * 2048 + col + bj * HALF)), g0, g1);
                    bf16_t* mp = MG + (size_t)row * D + col + bj * HALF;
#pragma unroll
                    for (int j = 0; j < 4; ++j) { a[j] = a[j] * sigmoidf_(g0[j]); b[j] = b[j] * sigmoidf_(g1[j]); }
                    if (u.z > 0) { f32x4 o0, o1; unpack8(*(const volatile u32x4*)mp, o0, o1); a = a + o0; b = b + o1; }
                    *(volatile u32x4*)mp = pack8(a, b); } }
    }
};
}

struct Params { const float* in[40]; float* out; unsigned char* ws; int ph_lo, ph_hi; };
enum { I_XP = 0, I_XS, I_MEMP, I_CAK, I_CAV, I_CMK, I_CMV, I_SRE, I_SIM, I_F1PRE, I_F1POST, I_F1G, I_F1U, I_F1D, I_MIXPRE, I_MIXPOST, I_WIN,
       I_SARE, I_SAIM, I_SLDT, I_SBRE, I_SBIM, I_SCRE, I_SCIM, I_SD, I_SWGLU, I_SBGLU, I_RELB, I_MEMNORM, I_WMK, I_WMV, I_WBS, I_WBA, I_WBM, I_WOUT,
       I_F2PRE, I_F2POST, I_F2G, I_F2U, I_F2D };

__device__ __forceinline__ void tr_item(const float* W, int K, int N, bf16_t* WT, int row_off, int inter, LAS float* scr, int item, int lane) {
    const int nblk = N / 32, kb = item / nblk, nb = item % nblk, k0 = 64 * kb, n0 = 32 * nb;
#pragma unroll 8
    for (int i = 0; i < 32; ++i) { const int kk = 2 * i + (lane >> 5); scr[kk * 33 + (lane & 31)] = __builtin_nontemporal_load(W + (size_t)(k0 + kk) * N + n0 + (lane & 31)); }
    LDS_WAIT();
    const int c = lane & 7;
#pragma unroll
    for (int j = 0; j < 4; ++j) { const int n = (lane >> 3) + 8 * j; const LAS float* s = scr + (8 * c) * 33 + n;
        u32x4 o; o.x = cvt_pk_bf16(s[0 * 33], s[1 * 33]); o.y = cvt_pk_bf16(s[2 * 33], s[3 * 33]); o.z = cvt_pk_bf16(s[4 * 33], s[5 * 33]); o.w = cvt_pk_bf16(s[6 * 33], s[7 * 33]);
        const int col = n0 + n; const int drow = inter ? (((col >> 7) << 8) + (col & 127) + row_off) : (row_off + col);
        *(u32x4*)(WT + (size_t)drow * K + k0 + 8 * c) = o; }
    LDS_WAIT();
}
__device__ __forceinline__ void rms_row_to_bf16(const float* xrow, const float* gain, bf16_t* orow, int lane) {
    f32x4 v[8]; float s = 0.f;
#pragma unroll
    for (int j = 0; j < 8; ++j) { v[j] = __builtin_nontemporal_load((const f32x4*)(xrow + 4 * lane + 256 * j)); s += (v[j][0] * v[j][0] + v[j][1] * v[j][1]) + (v[j][2] * v[j][2] + v[j][3] * v[j][3]); }
    const float rs = rsqrtf(wave_sum(s) * (1.0f / D) + EPS);
#pragma unroll
    for (int j = 0; j < 8; ++j) { const f32x4 gg = *(const f32x4*)(gain + 4 * lane + 256 * j);
        u32x2 w; w.x = cvt_pk_bf16(v[j][0] * rs * gg[0], v[j][1] * rs * gg[1]); w.y = cvt_pk_bf16(v[j][2] * rs * gg[2], v[j][3] * rs * gg[3]);
        *(u32x2*)(orow + 4 * lane + 256 * j) = w; }
}
__device__ __forceinline__ void cvt_copy(const float* src, bf16_t* dst, size_t n, int gw, int NGW, int lane) {
    for (size_t i = ((size_t)gw * 64 + lane) * 8; i < n; i += (size_t)NGW * 512) {
        const f32x4 a = __builtin_nontemporal_load((const f32x4*)(src + i)), b = __builtin_nontemporal_load((const f32x4*)(src + i + 4));
        *(u32x4*)(dst + i) = pg8::pack8(a, b); }
}


__device__ __forceinline__ int vpos_of(int key) { return (key >> 5) * 32 + ((key >> 2) & 3) * 8 + ((key >> 4) & 1) * 4 + (key & 3); }
template <class T> __device__ __forceinline__ void mvt_build(const T* src, int spitch, int scol0, bf16_t* dst, int nb, size_t gtid, size_t nthr) {
    for (size_t idx = gtid; idx < (size_t)nb * 4096; idx += nthr) {
        const int d = (int)(idx & 63), dc = (int)((idx >> 6) & 3), kb = (int)((idx >> 8) & 3), h = (int)((idx >> 10) & 3), b = (int)(idx >> 12);
        const T* sp = src + ((size_t)b * 256 + kb * 64) * spitch + scol0 + h * 256 + dc * 64 + d;
        bf16_t* dp = dst + ((((size_t)(b * 4 + h) * 4 + kb) * 4 + dc) * 64 + d) * 64;
#pragma unroll
        for (int c = 0; c < 8; ++c) { const int t = c >> 2, g = c & 3; float v[8];
#pragma unroll
            for (int i = 0; i < 8; ++i) { const int key = 32 * t + 16 * (i >> 2) + 4 * g + (i & 3);
                if constexpr (sizeof(T) == 4) v[i] = (float)sp[(size_t)key * spitch]; else v[i] = bf2f(sp[(size_t)key * spitch]); }
            u32x4 w; w.x = cvt_pk_bf16(v[0], v[1]); w.y = cvt_pk_bf16(v[2], v[3]); w.z = cvt_pk_bf16(v[4], v[5]); w.w = cvt_pk_bf16(v[6], v[7]);
            *(u32x4*)(dp + 8 * c) = w; }
    }
}

template <int MODE>
__device__ __forceinline__ void ew_phase(const Params& p, const float* gpost, const float* gpre, int gw, int NGW, int lane, int nsplit) {
    float* H = p.out; const bf16_t* Y = (const bf16_t*)(p.ws + WS_YO); const float* RSQ = (const float*)(p.ws + WS_RSQ); bf16_t* U = (bf16_t*)(p.ws + WS_U);
    const float c = (MODE == 2) ? 1.0f : 0.5f;
    for (int row = gw; row < M; row += NGW) {
        const float* hin = (MODE == 1) ? (row < MP ? p.in[I_XP] + (size_t)row * D : p.in[I_XS] + (size_t)(row - MP) * D) : H + (size_t)row * D;
        f32x4 yv[8]; float part = 0.f;
        if (row < MP) {
            part = lane < 32 ? *(const volatile float*)(RSQ + (size_t)row * 32 + lane) : 0.f;
#pragma unroll
            for (int j = 0; j < 8; ++j) { const u32x2 yw = __builtin_nontemporal_load((const u32x2*)(Y + (size_t)row * D + 4 * lane + 256 * j)); yv[j] = (f32x4){bflo(yw.x), bfhi(yw.x), bflo(yw.y), bfhi(yw.y)}; }
        } else {
            const float* zr = (const float*)(p.ws + WS_ZS) + (size_t)(row - MP) * D;
#pragma unroll
            for (int j = 0; j < 8; ++j) { f32x4 a = (f32x4){0.f, 0.f, 0.f, 0.f};
                for (int sl = 0; sl < nsplit; ++sl) { const u32x4 t = *(const volatile u32x4*)(zr + (size_t)sl * 256 * D + 4 * lane + 256 * j); a[0] += __uint_as_float(t.x); a[1] += __uint_as_float(t.y); a[2] += __uint_as_float(t.z); a[3] += __uint_as_float(t.w); }
                yv[j] = a; part += (a[0] * a[0] + a[1] * a[1]) + (a[2] * a[2] + a[3] * a[3]); }
        }
        const float rs = rsqrtf(wave_sum(part) * (1.0f / D) + EPS) * c;
        f32x4 hv[8]; float ss = 0.f;
#pragma unroll
        for (int j = 0; j < 8; ++j) { const int col = 4 * lane + 256 * j;
            const f32x4 h4 = __builtin_nontemporal_load((const f32x4*)(hin + col)); const f32x4 g4 = *(const f32x4*)(gpost + col);
            f32x4 hn; hn[0] = h4[0] + yv[j][0] * rs * g4[0]; hn[1] = h4[1] + yv[j][1] * rs * g4[1]; hn[2] = h4[2] + yv[j][2] * rs * g4[2]; hn[3] = h4[3] + yv[j][3] * rs * g4[3];
            hv[j] = hn; ss += (hn[0] * hn[0] + hn[1] * hn[1]) + (hn[2] * hn[2] + hn[3] * hn[3]);
            __builtin_nontemporal_store(hn, (f32x4*)(H + (size_t)row * D + col)); }
        if (MODE != 3) {
            const float rs2 = rsqrtf(wave_sum(ss) * (1.0f / D) + EPS);
#pragma unroll
            for (int j = 0; j < 8; ++j) { const int col = 4 * lane + 256 * j; const f32x4 gg = *(const f32x4*)(gpre + col);
                u32x2 w; w.x = cvt_pk_bf16(hv[j][0] * rs2 * gg[0], hv[j][1] * rs2 * gg[1]); w.y = cvt_pk_bf16(hv[j][2] * rs2 * gg[2], hv[j][3] * rs2 * gg[3]);
                *(u32x2*)(U + (size_t)row * D + col) = w; }
        }
    }
}

template <int NQ, int HD, bool BIAS, bool VTG>
__device__ __forceinline__ void attn_item(const bf16_t* Q, int qpitch, const bf16_t* K0, const bf16_t* V0, size_t kbstride, int pitch, int nreg,
                                          const bf16_t* Ks, const bf16_t* Vs, int pitch_s, int nvalid_s, bool has_s,
                                          int qpos0, int kpos_base, float scale, const float* bias_g, bf16_t* O, int opitch, LAS unsigned char* wl, int lane, const bf16_t* VT = nullptr) {
    const int fr = lane & 15, g = lane >> 4;
    LAS float* bl = (LAS float*)(wl + 9216);
    LAS bf16_t* vt = (LAS bf16_t*)wl;
    if (BIAS) { for (int i = lane; i < 257; i += 64) bl[i] = bias_g[i]; }
    bf16x8 qf[NQ][HD / 32];
#pragma unroll
    for (int nq = 0; nq < NQ; ++nq)
#pragma unroll
        for (int kd = 0; kd < HD / 32; ++kd) qf[nq][kd] = *(const bf16x8*)(Q + (size_t)(16 * nq + fr) * qpitch + 32 * kd + 8 * g);
    float mrow[NQ], lrow[NQ]; f32x4 o[HD / 16][NQ];
#pragma unroll
    for (int nq = 0; nq < NQ; ++nq) { mrow[nq] = -1e30f; lrow[nq] = 0.f;
#pragma unroll
        for (int md = 0; md < HD / 16; ++md) o[md][nq] = (f32x4){0.f, 0.f, 0.f, 0.f}; }
    LDS_WAIT();
    const int nkb = nreg + (has_s ? 1 : 0);
    const int vpos = (lane >> 5) * 32 + ((lane >> 2) & 3) * 8 + ((lane >> 4) & 1) * 4 + (lane & 3);
    for (int kb = 0; kb < nkb; ++kb) {
        const bool sp = kb >= nreg;
        const bf16_t* Kp = sp ? Ks : K0 + (size_t)kb * kbstride; const bf16_t* Vp = sp ? Vs : V0 + (size_t)kb * kbstride;
        const int pt = sp ? pitch_s : pitch, nv = sp ? nvalid_s : 64;
        f32x4 st[4][NQ];
#pragma unroll
        for (int mk = 0; mk < 4; ++mk) {
#pragma unroll
            for (int nq = 0; nq < NQ; ++nq) st[mk][nq] = (f32x4){0.f, 0.f, 0.f, 0.f};
            const bool kok = (16 * mk + fr) < nv;
#pragma unroll
            for (int kd = 0; kd < HD / 32; ++kd) {
                bf16x8 kf = (bf16x8){0, 0, 0, 0, 0, 0, 0, 0};
                if (kok) kf = *(const bf16x8*)(Kp + (size_t)(16 * mk + fr) * pt + 32 * kd + 8 * g);
#pragma unroll
                for (int nq = 0; nq < NQ; ++nq) st[mk][nq] = __builtin_amdgcn_mfma_f32_16x16x32_bf16(kf, qf[nq][kd], st[mk][nq], 0, 0, 0);
            }
        }
        __builtin_amdgcn_sched_barrier(0); asm volatile("s_nop 15" ::: "memory"); __builtin_amdgcn_sched_barrier(0);
        constexpr int NPRE = (NQ == 4) ? 4 : 8;
        u32x4 vpre[8];
        if (!VTG && HD == 64) { const bool kvok0 = lane < nv; const bf16_t* vrow0 = Vp + (size_t)lane * pt;
#pragma unroll
            for (int cch = 0; cch < NPRE; ++cch) { vpre[cch] = (u32x4){0u, 0u, 0u, 0u}; if (kvok0) vpre[cch] = *(const u32x4*)(vrow0 + 8 * cch); } }
        const bool farb = BIAS && (qpos0 - (kpos_base + 64 * kb + 63) >= 128);
        const float bfar = BIAS ? bl[256] : 0.f;
        bf16x8 pb[2][NQ];
#pragma unroll
        for (int nq = 0; nq < NQ; ++nq) {
            const int qpos = qpos0 + 16 * nq + fr;
            float mx = -1e30f;
#pragma unroll
            for (int mk = 0; mk < 4; ++mk)
#pragma unroll
                for (int j = 0; j < 4; ++j) { const int key = 16 * mk + 4 * g + j; float s = st[mk][nq][j] * scale;
                    if (BIAS) { if (farb) s += bfar; else { int dd = qpos - (kpos_base + 64 * kb + key); dd = dd < -128 ? -128 : (dd > 128 ? 128 : dd); s += bl[dd + 128]; } }
                    if (key >= nv) s = -1e30f;
                    st[mk][nq][j] = s; mx = fmaxf(mx, s); }
            mx = fmaxf(mx, __shfl_xor(mx, 16)); mx = fmaxf(mx, __shfl_xor(mx, 32));
            const float mnew = fmaxf(mrow[nq], mx), alpha = __expf(mrow[nq] - mnew);
            float ps = 0.f;
#pragma unroll
            for (int mk = 0; mk < 4; ++mk)
#pragma unroll
                for (int j = 0; j < 4; ++j) { const float pv = __expf(st[mk][nq][j] - mnew); st[mk][nq][j] = pv; ps += pv; }
            ps += __shfl_xor(ps, 16); ps += __shfl_xor(ps, 32);
            lrow[nq] = lrow[nq] * alpha + ps; mrow[nq] = mnew;
#pragma unroll
            for (int md = 0; md < HD / 16; ++md) o[md][nq] = o[md][nq] * alpha;
#pragma unroll
            for (int t = 0; t < 2; ++t) { u32x4 w;
                w.x = cvt_pk_bf16(st[2 * t][nq][0], st[2 * t][nq][1]); w.y = cvt_pk_bf16(st[2 * t][nq][2], st[2 * t][nq][3]);
                w.z = cvt_pk_bf16(st[2 * t + 1][nq][0], st[2 * t + 1][nq][1]); w.w = cvt_pk_bf16(st[2 * t + 1][nq][2], st[2 * t + 1][nq][3]);
                pb[t][nq] = __builtin_bit_cast(bf16x8, w); }
        }
#pragma unroll
        for (int dc = 0; dc < HD / 64; ++dc) {
            if (VTG) {
                const bf16_t* vtile = VT + (size_t)(kb * (HD / 64) + dc) * 4096;
#pragma unroll
                for (int md = 0; md < 4; ++md)
#pragma unroll
                    for (int t = 0; t < 2; ++t) { const bf16x8 va = *(const bf16x8*)(vtile + (16 * md + fr) * 64 + (t * 4 + g) * 8);
#pragma unroll
                        for (int nq = 0; nq < NQ; ++nq) o[4 * dc + md][nq] = __builtin_amdgcn_mfma_f32_16x16x32_bf16(va, pb[t][nq], o[4 * dc + md][nq], 0, 0, 0); }
                asm volatile("" ::: "memory");
                continue;
            }
            const bool kvok = lane < nv;
            const bf16_t* vrow = Vp + (size_t)lane * pt + 64 * dc;
#pragma unroll
            for (int cch = 0; cch < 8; ++cch) {
                u32x4 vv = (u32x4){0u, 0u, 0u, 0u};
                if (HD == 64 && cch < NPRE) vv = vpre[cch]; else if (kvok) vv = *(const u32x4*)(vrow + 8 * cch);
                vt[(8 * cch + 0) * 72 + vpos] = (bf16_t)(vv.x & 0xffffu); vt[(8 * cch + 1) * 72 + vpos] = (bf16_t)(vv.x >> 16);
                vt[(8 * cch + 2) * 72 + vpos] = (bf16_t)(vv.y & 0xffffu); vt[(8 * cch + 3) * 72 + vpos] = (bf16_t)(vv.y >> 16);
                vt[(8 * cch + 4) * 72 + vpos] = (bf16_t)(vv.z & 0xffffu); vt[(8 * cch + 5) * 72 + vpos] = (bf16_t)(vv.z >> 16);
                vt[(8 * cch + 6) * 72 + vpos] = (bf16_t)(vv.w & 0xffffu); vt[(8 * cch + 7) * 72 + vpos] = (bf16_t)(vv.w >> 16);
            }
            LDS_WAIT();
#pragma unroll
            for (int md = 0; md < 4; ++md)
#pragma unroll
                for (int t = 0; t < 2; ++t) { const bf16x8 va = *(const LAS bf16x8*)(wl + (16 * md + fr) * 144 + (t * 4 + g) * 16);
#pragma unroll
                    for (int nq = 0; nq < NQ; ++nq) o[4 * dc + md][nq] = __builtin_amdgcn_mfma_f32_16x16x32_bf16(va, pb[t][nq], o[4 * dc + md][nq], 0, 0, 0); }
            LDS_WAIT();
        }
    }
    __builtin_amdgcn_sched_barrier(0); asm volatile("s_nop 15" ::: "memory"); __builtin_amdgcn_sched_barrier(0);
#pragma unroll
    for (int nq = 0; nq < NQ; ++nq) { const float inv = 1.0f / lrow[nq];
#pragma unroll
        for (int md = 0; md < HD / 16; ++md) { const f32x4 v = o[md][nq] * inv; u32x2 w; w.x = cvt_pk_bf16(v[0], v[1]); w.y = cvt_pk_bf16(v[2], v[3]);
            *(u32x2*)(O + (size_t)(16 * nq + fr) * opitch + 16 * md + 4 * g) = w; } }
}

__device__ __forceinline__ float gelu_tanh(float x) { const float z = 0.7978845608028654f * (x + 0.044715f * x * x * x); const float e = __expf(2.0f * z); return 0.5f * x * (2.0f - 2.0f * __builtin_amdgcn_rcpf(1.0f + e)); }
template <bool FULL>
__device__ __forceinline__ void ssm_run(const Params& p, int gi, size_t row0, int nsub, float& s_re, float& s_im, LAS unsigned char* wl, int lane) {
    const int fr = lane & 15, g = lane >> 4;
    const bf16_t* PROJ = (const bf16_t*)(p.ws + WS_BIG); bf16_t* YS = (bf16_t*)(p.ws + WS_YS);
    const float* SAB = (const float*)(p.ws + WS_SAB); const bf16_t* SBB = (const bf16_t*)(p.ws + WS_SBB); const bf16_t* SCM = (const bf16_t*)(p.ws + WS_SCM);
    const f32x4 ab = *(const f32x4*)(SAB + (size_t)(gi * 64 + lane) * 4);
    const float a_re = ab[0], a_im = ab[1];
    bf16x4 bbf[8];
#pragma unroll
    for (int t = 0; t < 8; ++t) bbf[t] = *(const bf16x4*)(SBB + (size_t)(gi * 128 + 16 * t + fr) * 16 + 4 * g);
    bf16x8 cmf[4]; float dval = 0.f;
    if (FULL) {
#pragma unroll
        for (int kk = 0; kk < 4; ++kk) cmf[kk] = *(const bf16x8*)(SCM + (size_t)(gi * 16 + fr) * 128 + 32 * kk + 8 * g);
        dval = p.in[I_SD][gi * 16 + fr];
    }
    LAS float* BUl = (LAS float*)wl;
    LAS bf16_t* Sl = (LAS bf16_t*)(wl + 8448);
    bf16x4 uf_nx = *(const bf16x4*)(PROJ + (row0 + fr) * NIN5 + gi * 16 + 4 * g);
    for (int sc = 0; sc < nsub; ++sc) {
        const size_t t0 = row0 + 16 * sc;
        const bf16x4 uf = uf_nx;
        if (sc + 1 < nsub) uf_nx = *(const bf16x4*)(PROJ + (t0 + 16 + fr) * NIN5 + gi * 16 + 4 * g);
        bf16_t upre[4];
        if (FULL) {
#pragma unroll
            for (int j = 0; j < 4; ++j) upre[j] = PROJ[(t0 + 4 * g + j) * NIN5 + gi * 16 + fr];
        }
        f32x4 bu[8];
#pragma unroll
        for (int t = 0; t < 8; ++t) bu[t] = __builtin_amdgcn_mfma_f32_16x16x16bf16_1k(bbf[t], uf, (f32x4){0.f, 0.f, 0.f, 0.f}, 0, 0, 0);
        __builtin_amdgcn_sched_barrier(0); asm volatile("s_nop 15\n\ts_nop 15" ::: "memory"); __builtin_amdgcn_sched_barrier(0);
#pragma unroll
        for (int t = 0; t < 8; ++t) *(LAS f32x4*)(BUl + fr * 132 + 16 * t + 4 * g) = bu[t];
        LDS_WAIT();
        float br[16], bi[16];
#pragma unroll
        for (int t = 0; t < 16; ++t) { br[t] = BUl[t * 132 + lane]; bi[t] = BUl[t * 132 + 64 + lane]; }
#pragma unroll
        for (int t = 0; t < 16; ++t) {
            const float nr = fmaf(a_re, s_re, fmaf(-a_im, s_im, br[t])), ni = fmaf(a_re, s_im, fmaf(a_im, s_re, bi[t]));
            s_re = nr; s_im = ni;
            if (FULL) { const unsigned w = cvt_pk_bf16(nr, ni); Sl[t * 136 + lane] = (bf16_t)(w & 0xffffu); Sl[t * 136 + 64 + lane] = (bf16_t)(w >> 16); }
        }
        if (FULL) {
            LDS_WAIT();
            f32x4 y = (f32x4){0.f, 0.f, 0.f, 0.f};
#pragma unroll
            for (int kk = 0; kk < 4; ++kk) { const bf16x8 sf = *(const LAS bf16x8*)(wl + 8448 + (fr * 136 + 32 * kk + 8 * g) * 2);
                y = __builtin_amdgcn_mfma_f32_16x16x32_bf16(sf, cmf[kk], y, 0, 0, 0); }
            __builtin_amdgcn_sched_barrier(0); asm volatile("s_nop 15\n\ts_nop 15" ::: "memory"); __builtin_amdgcn_sched_barrier(0);
#pragma unroll
            for (int j = 0; j < 4; ++j) { const size_t tok = t0 + 4 * g + j; const float uu = bf2f(upre[j]);
                const float yy = gelu_tanh(y[j] + dval * uu); YS[tok * 1024 + gi * 16 + fr] = (bf16_t)(cvt_pk_bf16(yy, 0.f) & 0xffffu); }
        }
        LDS_WAIT();
    }
}

#define XB_TMO      128
#define XB_XCNT(j)  (256  + 64 * (j))
#define XB_XSUB(j)  (1280 + 64 * (j))
#define XB_XGEN(j)  (2304 + 64 * (j))
#define XB_TOP      3328
#define XB_TOPGEN   3392
#define XCD_BAR_WORDS 3456
#define XB_SPIN_CAP (1u << 18)

__device__ __forceinline__ unsigned xb_ld(unsigned* p)              { return __hip_atomic_load(p, __ATOMIC_RELAXED, __HIP_MEMORY_SCOPE_AGENT); }
__device__ __forceinline__ unsigned xb_add(unsigned* p, unsigned v) { return __hip_atomic_fetch_add(p, v, __ATOMIC_RELAXED, __HIP_MEMORY_SCOPE_AGENT); }
__device__ __forceinline__ unsigned xb_xcc_id() { return (unsigned)__builtin_amdgcn_s_getreg((3 << 11) | 20) & 0xFu; }
#define XB_SPIN(cond, bar) do { unsigned _sp = 0; while (cond) { __builtin_amdgcn_s_sleep(1); \
    if ((++_sp & 255u) == 0u) { if (xb_ld(&(bar)[XB_TMO])) break; if (_sp > XB_SPIN_CAP) { atomicAdd(&(bar)[XB_TMO], 1u); break; } } } } while (0)

struct XcdBarrier {
    unsigned* bar; unsigned x;
    volatile LAS unsigned* st;
};

__device__ __forceinline__ XcdBarrier xcd_barrier_post(unsigned* bar, volatile LAS unsigned* st) {
    XcdBarrier b; b.bar = bar; b.x = xb_xcc_id(); b.st = st;
    if (threadIdx.x == 0) (void)xb_add(&bar[XB_XCNT(b.x)], 1u);
    return b;
}
__device__ __forceinline__ void xcd_barrier_complete(unsigned* bar, unsigned x, unsigned& nloc, unsigned& nx) {
    const unsigned G = gridDim.x * gridDim.y * gridDim.z;
    unsigned sum, cnt, mine, sp = 0u;
    for (;;) {
        sum = 0u; cnt = 0u; mine = 0u;
#pragma unroll
        for (unsigned j = 0; j < 16; ++j) { const unsigned c = xb_ld(&bar[XB_XCNT(j)]); sum += c; cnt += (c > 0u) ? 1u : 0u; mine = (j == x) ? c : mine; }
        if (sum == G) break;
        __builtin_amdgcn_s_sleep(1);
        if ((++sp & 255u) == 0u) { if (xb_ld(&bar[XB_TMO])) break; if (sp > XB_SPIN_CAP) { atomicAdd(&bar[XB_TMO], 1u); break; } }
    }
    nloc = mine > 0u ? mine : 1u; nx = cnt > 0u ? cnt : 1u;
}

__device__ __forceinline__ void xcd_barrier(const XcdBarrier& b) {
    asm volatile("s_waitcnt vmcnt(0)" ::: "memory");
    __syncthreads();
    if (threadIdx.x == 0) {
        unsigned* bar = b.bar;
        __builtin_amdgcn_s_waitcnt(0);
        unsigned nloc = b.st[0], nx = b.st[1];
        if (nloc == 0u) { xcd_barrier_complete(bar, b.x, nloc, nx); b.st[0] = nloc; b.st[1] = nx; }
        const unsigned old = xb_add(&bar[XB_XSUB(b.x)], 1u);
        const unsigned gen = old / nloc;
        if (old + 1u == (gen + 1u) * nloc) {
            __builtin_amdgcn_fence(__ATOMIC_RELEASE, "agent");
            asm volatile("s_waitcnt vmcnt(0)" ::: "memory");
            const unsigned og = xb_add(&bar[XB_TOP], 1u);
            const unsigned tg = og / nx;
            if (og + 1u == (tg + 1u) * nx) xb_add(&bar[XB_TOPGEN], 1u);
            else XB_SPIN(xb_ld(&bar[XB_TOPGEN]) == tg, bar);
            __builtin_amdgcn_fence(__ATOMIC_ACQUIRE, "agent");
            xb_add(&bar[XB_XGEN(b.x)], 1u);
            asm volatile("s_waitcnt vmcnt(0)" ::: "memory");
        } else {
            XB_SPIN(xb_ld(&bar[XB_XGEN(b.x)]) == gen, bar);
            __builtin_amdgcn_fence(__ATOMIC_ACQUIRE, "agent");
            asm volatile("s_waitcnt vmcnt(0)" ::: "memory");
        }
    }
    __syncthreads();
}


__global__ void __launch_bounds__(512, 2) mega_fwd(Params p) {
    extern __shared__ __attribute__((aligned(16))) unsigned char lds_raw[];
    cg::grid_group grid = cg::this_grid();
    LAS unsigned char* lds = (LAS unsigned char*)lds_raw;
    const int wave = __builtin_amdgcn_readfirstlane(threadIdx.x >> 6);
    const int G = gridDim.x, gw = blockIdx.x * 8 + wave, NGW = G * 8;
    LAS unsigned char* wl = lds + wave * WLDS;
    unsigned char* ws = p.ws;
    bf16_t* U = (bf16_t*)(ws + WS_U); bf16_t* BIG = (bf16_t*)(ws + WS_BIG); bf16_t* YO = (bf16_t*)(ws + WS_YO); float* RSQ = (float*)(ws + WS_RSQ);
    bf16_t* OS = YO; bf16_t* OA = YO + (size_t)M * 1024; bf16_t* OM = YO + (size_t)2 * M * 1024; bf16_t* YS = (bf16_t*)(ws + WS_YS);
    volatile LAS unsigned* bst = (volatile LAS unsigned*)(lds + 131072 + 64);
    if (threadIdx.x < 2) bst[threadIdx.x] = 0u;
    __syncthreads();
    const XcdBarrier xbar = xcd_barrier_post((unsigned*)ws, bst);
    const int lo = p.ph_lo, hi = p.ph_hi;
#define IN(k) (lo <= (k) && (k) < hi)
#define GSYNC() do { asm volatile("s_waitcnt vmcnt(0) lgkmcnt(0)" ::: "memory"); grid.sync(); __builtin_amdgcn_fence(__ATOMIC_ACQUIRE, "agent"); asm volatile("s_waitcnt vmcnt(0)" ::: "memory"); } while (0)
#define XSYNC() do { xcd_barrier(xbar); } while (0)
#define SEAM(k) do { if (IN(k) && IN((k) + 1)) { if ((k) == 0) GSYNC(); else XSYNC(); } } while (0)

    if (IN(0)) {
        const int lane = lane_id();
        LAS float* scr = (LAS float*)wl;
        struct TJ { int idx, K, N; size_t dst; int roff, inter; };
        const TJ jobs[15] = {
            {I_F1G, D, FF, WS_WGU1, 0, 1}, {I_F1U, D, FF, WS_WGU1, 128, 1}, {I_F1D, FF, D, WS_WD1, 0, 0}, {I_WIN, D, 11264, WS_WIN, 0, 0},
            {I_SWGLU, 1024, 1024, WS_WGLU, 0, 0}, {I_WMK, D, 1024, WS_WMKV, 0, 0}, {I_WMV, D, 1024, WS_WMKV, 1024, 0},
            {I_WBS, 1024, D, WS_WBR, 0, 0}, {I_WBA, 1024, D, WS_WBR + (size_t)2048 * 1024 * 2, 0, 0}, {I_WBM, 1024, D, WS_WBR + (size_t)2 * 2048 * 1024 * 2, 0, 0},
            {I_WOUT, D, D, WS_WOUT, 0, 0}, {I_F2G, D, FF, WS_WGU2, 0, 1}, {I_F2U, D, FF, WS_WGU2, 128, 1}, {I_F2D, FF, D, WS_WD2, 0, 0}, {0, 0, 0, 0, 0, 0}};
        int base = 0;
#pragma unroll
        for (int j = 0; j < 14; ++j) {
            const int K = jobs[j].K, N = jobs[j].N, ni = (K / 64) * (N / 32);
            int first = (gw - (base % NGW)); if (first < 0) first += NGW;
            for (int it = first; it < ni; it += NGW) tr_item(p.in[jobs[j].idx], K, N, (bf16_t*)(ws + jobs[j].dst), jobs[j].roff, jobs[j].inter, scr, it, lane);
            base += ni;
        }
        for (int row = gw; row < M; row += NGW)
            rms_row_to_bf16(row < MP ? p.in[I_XP] + (size_t)row * D : p.in[I_XS] + (size_t)(row - MP) * D, p.in[I_F1PRE], U + (size_t)row * D, lane);
        for (int row = gw; row < 2048; row += NGW) rms_row_to_bf16(p.in[I_MEMP] + (size_t)row * D, p.in[I_MEMNORM], (bf16_t*)(ws + WS_MN) + (size_t)row * D, lane);
        cvt_copy(p.in[I_CAK], (bf16_t*)(ws + WS_CK), (size_t)16 * 512 * 1024, gw, NGW, lane);
        cvt_copy(p.in[I_CAV], (bf16_t*)(ws + WS_CV), (size_t)16 * 512 * 1024, gw, NGW, lane);
        cvt_copy(p.in[I_CMK], (bf16_t*)(ws + WS_CMK), (size_t)16 * 256 * 1024, gw, NGW, lane);
        mvt_build<float>(p.in[I_CMV], 1024, 0, (bf16_t*)(ws + WS_CMVT), 16, (size_t)gw * 64 + lane, (size_t)NGW * 64);
        {
            const int idx = (NGW - 1 - gw) * 64 + lane;
            if (idx < 4096) {
                const int gi = idx >> 6, pp = idx & 63;
                const double are = (double)p.in[I_SARE][idx], aim = (double)p.in[I_SAIM][idx], dt = exp((double)p.in[I_SLDT][gi]);
                const double mag = exp(are * dt), abr = mag * cos(aim * dt), abi = mag * sin(aim * dt);
                const double magL = exp(are * dt * (double)SEG), alr = magL * cos(aim * dt * (double)SEG), ali = magL * sin(aim * dt * (double)SEG);
                const double den = are * are + aim * aim, nr = abr - 1.0, ni = abi;
                const double cr = (nr * are + ni * aim) / den, ci = (ni * are - nr * aim) / den;
                float* SAB = (float*)(ws + WS_SAB); bf16_t* SBB = (bf16_t*)(ws + WS_SBB); bf16_t* SCM = (bf16_t*)(ws + WS_SCM);
                *(f32x4*)(SAB + (size_t)idx * 4) = (f32x4){(float)abr, (float)abi, (float)alr, (float)ali};
#pragma unroll
                for (int h = 0; h < 16; h += 2) {
                    const double br0 = p.in[I_SBRE][(size_t)idx * 16 + h], bi0 = p.in[I_SBIM][(size_t)idx * 16 + h], br1 = p.in[I_SBRE][(size_t)idx * 16 + h + 1], bi1 = p.in[I_SBIM][(size_t)idx * 16 + h + 1];
                    *(unsigned*)(SBB + (size_t)(gi * 128 + pp) * 16 + h) = cvt_pk_bf16((float)(cr * br0 - ci * bi0), (float)(cr * br1 - ci * bi1));
                    *(unsigned*)(SBB + (size_t)(gi * 128 + 64 + pp) * 16 + h) = cvt_pk_bf16((float)(cr * bi0 + ci * br0), (float)(cr * bi1 + ci * br1));
                }
#pragma unroll
                for (int h = 0; h < 16; ++h) {
                    SCM[(size_t)(gi * 16 + h) * 128 + pp] = (bf16_t)(cvt_pk_bf16(p.in[I_SCRE][(size_t)(gi * 16 + h) * 64 + pp], 0.f) & 0xffffu);
                    SCM[(size_t)(gi * 16 + h) * 128 + 64 + pp] = (bf16_t)(cvt_pk_bf16(-p.in[I_SCIM][(size_t)(gi * 16 + h) * 64 + pp], 0.f) & 0xffffu);
                }
            }
        }
    }
    SEAM(0);
    if (IN(1)) {
        { pg8::Gemm g{U, (const bf16_t*)(ws + WS_WGU1), D, 0, 0}; pg8::Sched S; S.init(M, 2 * FF, G, blockIdx.x, 1); pg8::EpiSwiglu E{BIG}; pg8::gemm_phase(lds, g, S, E, wave); }
        { pg8::Gemm g{(const bf16_t*)(ws + WS_MN), (const bf16_t*)(ws + WS_WMKV), D, 0, 0}; pg8::Sched S; S.init(2048, 2048, G, (blockIdx.x + G - 44) % G, 1); pg8::EpiMemKV E{(bf16_t*)(ws + WS_MKV), p.out}; pg8::gemm_phase(lds, g, S, E, wave); }
    }
    SEAM(1);
    if (IN(2)) {
        { pg8::Gemm g{BIG, (const bf16_t*)(ws + WS_WD1), FF, 0, 0}; pg8::Sched S; S.init(MP, D, G, blockIdx.x, 1); pg8::EpiDown E{YO, RSQ}; pg8::gemm_phase(lds, g, S, E, wave); }
        { pg8::Gemm g{BIG + (size_t)MP * FF, (const bf16_t*)(ws + WS_WD1), 512, 1024, 1024, FF}; pg8::SchedSplit S{8, 11, G, (int)blockIdx.x}; pg8::EpiSplitAcc E{(float*)(ws + WS_ZS)}; pg8::gemm_phase(lds, g, S, E, wave); }
    }
    SEAM(2);
    if (IN(3)) { mvt_build<bf16_t>((const bf16_t*)(ws + WS_MKV), 2048, 1024, (bf16_t*)(ws + WS_MVT), 8, (size_t)gw * 64 + lane_id(), (size_t)NGW * 64);
        ew_phase<1>(p, p.in[I_F1POST], p.in[I_MIXPRE], gw, NGW, lane_id(), 11); }
    SEAM(3);
    if (IN(4)) { pg8::Gemm g{U, (const bf16_t*)(ws + WS_WIN), D, 0, 0}; pg8::Sched S; S.init(M, NIN5, G, blockIdx.x, 1); pg8::EpiWin E{BIG, p.out}; pg8::gemm_phase(lds, g, S, E, wave); }
    SEAM(4);
    if (IN(5)) {
        const bf16_t* PROJ = BIG;
        constexpr int N_SA = 8 * 64 * (NSEG - 1), N_BP = 8 * 64 * 16, N_MP = 8 * 256 * 4, N_BS = 256, N_MSs = 64;
        {
            const int lane = lane_id();
            const bool xmap = (G % 8 == 0);
            const int wxs = xmap ? (G / 8) * 8 : NGW, wx0 = xmap ? (int)(blockIdx.x >> 3) * 8 + wave : gw;
            for (int r0 = wx0; r0 < (xmap ? 1024 : N_BP); r0 += wxs) {
                const int r = xmap ? ((int)(blockIdx.x & 7) << 10) + r0 : r0;
                const int h = r & 15, c = (r >> 4) & 63, b = r >> 10;
                const int c0 = c >= 8 ? c - 8 : 0; const size_t qrow = (size_t)b * TP + c * 64, krow = (size_t)b * TP + c0 * 64;
                attn_item<4, 64, true, false>(PROJ + qrow * NIN5 + 1024 + h * 64, NIN5, PROJ + krow * NIN5 + 2048 + h * 64, PROJ + krow * NIN5 + 3072 + h * 64, (size_t)64 * NIN5, NIN5, c - c0 + 1,
                                       nullptr, nullptr, 0, 0, false, c * 64, c0 * 64, 0.125f, p.in[I_RELB] + h * 257, OA + qrow * 1024 + h * 64, 1024, wl, lane);
            }
        }
        {
            const int lane = lane_id();
            for (int r = (gw + NGW - 512) % NGW; r < N_SA; r += NGW) {
                const int gi = r & 63, rest = r >> 6, seg = rest % (NSEG - 1), b = rest / (NSEG - 1), bg = b * 64 + gi;
                float s_re = 0.f, s_im = 0.f;
                ssm_run<false>(p, gi, (size_t)b * TP + seg * SEG, SEG / 16, s_re, s_im, wl, lane);
                float* SE = (float*)(ws + WS_SE) + ((size_t)bg * NSEG + seg) * 128; SE[lane] = s_re; SE[64 + lane] = s_im;
            }
        }
        {
            const int lane = lane_id();
            const bool xmap = (G % 8 == 0);
            const int wxs = xmap ? (G / 8) * 8 : NGW, wx0 = xmap ? (int)(blockIdx.x >> 3) * 8 + wave : gw;
            for (int r0 = wx0; r0 < (xmap ? 1024 : N_MP); r0 += wxs) {
                const int r = xmap ? ((int)(blockIdx.x & 7) << 10) + r0 : r0;
                const int h = r & 3, qb = (r >> 2) & 255, b = r >> 10;
                const size_t qrow = (size_t)b * TP + qb * 16; const bf16_t* MKV = (const bf16_t*)(ws + WS_MKV) + (size_t)b * 256 * 2048 + h * 256;
                attn_item<1, 256, false, true>(PROJ + qrow * NIN5 + 4096 + h * 256, NIN5, MKV, MKV + 1024, (size_t)64 * 2048, 2048, 4,
                                         nullptr, nullptr, 0, 0, false, 0, 0, 0.0625f, nullptr, OM + qrow * 1024 + h * 256, 1024, wl, lane, (const bf16_t*)(ws + WS_MVT) + (size_t)(b * 4 + h) * 65536);
            }
        }
        {
            const int lane = lane_id();
            for (int r = (gw + NGW - 1536) % NGW; r < N_BS; r += NGW) {
                const int h = r & 15, b = r >> 4; const size_t qrow = (size_t)MP + b * 16;
                const bf16_t* CK = (const bf16_t*)(ws + WS_CK) + (size_t)b * 512 * 1024 + h * 64; const bf16_t* CV = (const bf16_t*)(ws + WS_CV) + (size_t)b * 512 * 1024 + h * 64;
                attn_item<1, 64, true, false>(PROJ + qrow * NIN5 + 1024 + h * 64, NIN5, CK, CV, (size_t)64 * 1024, 1024, 8,
                                       PROJ + qrow * NIN5 + 2048 + h * 64, PROJ + qrow * NIN5 + 3072 + h * 64, NIN5, 16, true, 4096, 3584, 0.125f, p.in[I_RELB] + h * 257,
                                       OA + qrow * 1024 + h * 64, 1024, wl, lane);
            }
        }
        {
            const int lane = lane_id();
            for (int r = (gw + NGW - 1800) % NGW; r < N_MSs; r += NGW) {
                const int h = r & 3, b = r >> 2; const size_t qrow = (size_t)MP + b * 16;
                const bf16_t* CMK = (const bf16_t*)(ws + WS_CMK) + (size_t)b * 256 * 1024 + h * 256; const bf16_t* CMV = (const bf16_t*)(ws + WS_CMV) + (size_t)b * 256 * 1024 + h * 256;
                attn_item<1, 256, false, true>(PROJ + qrow * NIN5 + 4096 + h * 256, NIN5, CMK, CMV, (size_t)64 * 1024, 1024, 4,
                                         nullptr, nullptr, 0, 0, false, 0, 0, 0.0625f, nullptr, OM + qrow * 1024 + h * 256, 1024, wl, lane, (const bf16_t*)(ws + WS_CMVT) + (size_t)(b * 4 + h) * 65536);
            }
        }
    }
    SEAM(5);
    if (IN(6)) {
        const int lane = lane_id();
        constexpr int N_SB = 8 * 64 * NSEG, N_SS = 16 * 64;
        const float* SAB = (const float*)(ws + WS_SAB);
        for (int it = gw; it < N_SB + N_SS; it += NGW) {
            if (it < N_SB) {
                const int gi = it & 63, seg = (it >> 6) & (NSEG - 1), b = it >> 10, bg = b * 64 + gi;
                const f32x4 ab = *(const f32x4*)(SAB + (size_t)(gi * 64 + lane) * 4);
                float s_re = 0.f, s_im = 0.f; const float* SE = (const float*)(ws + WS_SE) + (size_t)bg * NSEG * 128;
                for (int i = 0; i < seg; ++i) { const float er = SE[i * 128 + lane], ei = SE[i * 128 + 64 + lane];
                    const float nr = fmaf(ab[2], s_re, fmaf(-ab[3], s_im, er)), ni = fmaf(ab[2], s_im, fmaf(ab[3], s_re, ei)); s_re = nr; s_im = ni; }
                ssm_run<true>(p, gi, (size_t)b * TP + seg * SEG, SEG / 16, s_re, s_im, wl, lane);
                if (seg == NSEG - 1) { p.out[O_SRE_P + (size_t)bg * 64 + lane] = s_re; p.out[O_SIM_P + (size_t)bg * 64 + lane] = s_im; }
            } else {
                const int bg = it - N_SB, gi = bg & 63, b = bg >> 6;
                float s_re = p.in[I_SRE][(size_t)bg * 64 + lane], s_im = p.in[I_SIM][(size_t)bg * 64 + lane];
                ssm_run<true>(p, gi, (size_t)MP + b * 16, 1, s_re, s_im, wl, lane);
                p.out[O_SRE_S + (size_t)bg * 64 + lane] = s_re; p.out[O_SIM_S + (size_t)bg * 64 + lane] = s_im;
            }
        }
    }
    SEAM(6);
    if (IN(7)) {
        { pg8::Gemm g{YS, (const bf16_t*)(ws + WS_WGLU), 1024, 0, 0}; pg8::Sched S; S.init(M, 1024, G, blockIdx.x, 1); pg8::EpiGlu E{YS, p.in[I_SBGLU], OS}; pg8::gemm_phase(lds, g, S, E, wave); }
        { pg8::Gemm g{U, (const bf16_t*)(ws + WS_WIN) + (size_t)NIN5 * D, D, 0, 0}; pg8::Sched S; S.init(M, NGATE, G, (blockIdx.x + G - 4) % G, 1); pg8::EpiGate E{BIG};
        pg8::gemm_phase(lds, g, S, E, wave); }
    }
    SEAM(7);
    if (IN(8)) {
        pg8::Gemm g{OS, (const bf16_t*)(ws + WS_WBR), 1024, (size_t)M * 1024 * 2, (size_t)2048 * 1024 * 2}; pg8::Sched S; S.init(M, D, G, blockIdx.x, 3); pg8::EpiBranch E{BIG, U}; pg8::gemm_phase(lds, g, S, E, wave); }
    SEAM(8);
    if (IN(9)) {
        { pg8::Gemm g{U, (const bf16_t*)(ws + WS_WOUT), D, 0, 0}; pg8::Sched S; S.init(MP, D, G, blockIdx.x, 1); pg8::EpiDown E{YO, RSQ}; pg8::gemm_phase(lds, g, S, E, wave); }
        { pg8::Gemm g{U + (size_t)MP * D, (const bf16_t*)(ws + WS_WOUT), 512, 1024, 1024, D}; pg8::SchedSplit S{8, 4, G, (int)blockIdx.x}; pg8::EpiSplitAcc E{(float*)(ws + WS_ZS)}; pg8::gemm_phase(lds, g, S, E, wave); }
    }
    SEAM(9);
    if (IN(10)) ew_phase<2>(p, p.in[I_MIXPOST], p.in[I_F2PRE], gw, NGW, lane_id(), 4);
    SEAM(10);
    if (IN(11)) {
        pg8::Gemm g{U, (const bf16_t*)(ws + WS_WGU2), D, 0, 0}; pg8::Sched S; S.init(M, 2 * FF, G, blockIdx.x, 1); pg8::EpiSwiglu E{BIG}; pg8::gemm_phase(lds, g, S, E, wave); }
    SEAM(11);
    if (IN(12)) {
        { pg8::Gemm g{BIG, (const bf16_t*)(ws + WS_WD2), FF, 0, 0}; pg8::Sched S; S.init(MP, D, G, blockIdx.x, 1); pg8::EpiDown E{YO, RSQ}; pg8::gemm_phase(lds, g, S, E, wave); }
        { pg8::Gemm g{BIG + (size_t)MP * FF, (const bf16_t*)(ws + WS_WD2), 512, 1024, 1024, FF}; pg8::SchedSplit S{8, 11, G, (int)blockIdx.x}; pg8::EpiSplitAcc E{(float*)(ws + WS_ZS)}; pg8::gemm_phase(lds, g, S, E, wave); }
    }
    SEAM(12);
    if (IN(13)) ew_phase<3>(p, p.in[I_F2POST], nullptr, gw, NGW, lane_id(), 11);
#undef IN
#undef SEAM
}

extern "C" void kernel_launch(void* const* d_in, const int* in_sizes, int n_in, void* d_out, int out_size, void* d_ws, size_t ws_size, hipStream_t stream) {
    static int grid = 0;
    if (grid == 0) {
        if (n_in != 40 || ws_size < WS_END) { fprintf(stderr, "kernel_launch: unexpected n_in %d / ws %zu\n", n_in, ws_size); grid = -1; return; }
        int dev = 0, cus = 0, per_cu = 0;
        hipGetDevice(&dev); hipDeviceGetAttribute(&cus, hipDeviceAttributeMultiprocessorCount, dev);
        if (hipFuncSetAttribute((const void*)mega_fwd, hipFuncAttributeMaxDynamicSharedMemorySize, LDS_BYTES) != hipSuccess) { fprintf(stderr, "kernel_launch: hipFuncSetAttribute failed\n"); grid = -1; return; }
        if (hipOccupancyMaxActiveBlocksPerMultiprocessor(&per_cu, (const void*)mega_fwd, 512, LDS_BYTES) != hipSuccess || per_cu < 1) { fprintf(stderr, "kernel_launch: occupancy query says %d\n", per_cu); per_cu = 1; }
        (void)hipGetLastError();
        grid = cus * per_cu;
    }
    if (grid < 0) return;
    if (hipMemsetAsync(d_ws, 0, 16384, stream) != hipSuccess) { fprintf(stderr, "kernel_launch: memset of barrier words failed\n"); return; }
    Params p{};
    for (int i = 0; i < 40; ++i) p.in[i] = (const float*)d_in[i];
    p.out = (float*)d_out; p.ws = (unsigned char*)d_ws; p.ph_lo = 0; p.ph_hi = 14;
    void* args[] = {&p};
    hipError_t e = hipLaunchCooperativeKernel((const void*)mega_fwd, dim3(grid), dim3(512), args, LDS_BYTES, stream);
    if (e != hipSuccess) fprintf(stderr, "cooperative launch failed: %s (grid %d)\n", hipGetErrorString(e), grid);
}
```

```cpp
#include <hip/hip_runtime.h>
#include <hip/hip_cooperative_groups.h>
#include <cstdio>
#include <cstdint>
namespace cg = cooperative_groups;

#define LAS __attribute__((address_space(3)))
typedef unsigned short bf16_t;
typedef short bf16x8 __attribute__((ext_vector_type(8)));
typedef short bf16x4 __attribute__((ext_vector_type(4)));
typedef float f32x4 __attribute__((ext_vector_type(4)));
typedef unsigned u32x4 __attribute__((ext_vector_type(4)));
typedef unsigned u32x2 __attribute__((ext_vector_type(2)));

constexpr int D = 2048, MP = 32768, MS = 256, M = MP + MS, FF = 5632, NIN5 = 5120, NGATE = 6144, TP = 4096;
constexpr float EPS = 1e-6f;
constexpr int SEG = 256, NSEG = TP / SEG;
constexpr size_t O_Y = 0;
constexpr size_t O_ATTK_P = (size_t)M * D;
constexpr size_t O_ATTV_P = O_ATTK_P + 4194304;
constexpr size_t O_MEMK_P = O_ATTV_P + 4194304;
constexpr size_t O_MEMV_P = O_MEMK_P + 2097152;
constexpr size_t O_SRE_P = O_MEMV_P + 2097152;
constexpr size_t O_SIM_P = O_SRE_P + 32768;
constexpr size_t O_ATTK_S = O_SIM_P + 32768;
constexpr size_t O_ATTV_S = O_ATTK_S + 262144;
constexpr size_t O_SRE_S = O_ATTV_S + 262144;
constexpr size_t O_SIM_S = O_SRE_S + 65536;
constexpr size_t MiB = 1u << 20;
constexpr size_t WS_WGU1 = 1 * MiB, WS_WD1 = 45 * MiB, WS_WIN = 67 * MiB, WS_WGLU = 111 * MiB, WS_WMKV = 113 * MiB, WS_WBR = 121 * MiB,
                 WS_WOUT = 133 * MiB, WS_WGU2 = 141 * MiB, WS_WD2 = 185 * MiB;
constexpr size_t WS_YS = 1 * MiB;
constexpr size_t WS_U = 207 * MiB;
constexpr size_t WS_BIG = 336 * MiB;
constexpr size_t WS_YO = 723 * MiB;
constexpr size_t WS_MN = 917 * MiB, WS_MKV = 925 * MiB, WS_CK = 933 * MiB, WS_CV = 949 * MiB, WS_CMK = 965 * MiB, WS_CMV = 973 * MiB;
constexpr size_t WS_RSQ = 981 * MiB;
constexpr size_t WS_SE = 986 * MiB;
constexpr size_t WS_SAB = 990 * MiB;
constexpr size_t WS_SBB = 990 * MiB + 65536;
constexpr size_t WS_SCM = 990 * MiB + 65536 + 262144;
constexpr size_t WS_MVT = 992 * MiB;
constexpr size_t WS_CMVT = 996 * MiB;
constexpr size_t WS_ZS = 691 * MiB;
constexpr size_t WS_END = 1004 * MiB;
constexpr int LDS_BYTES = 147456;
constexpr int WLDS = 16384;

__device__ __forceinline__ unsigned cvt_pk_bf16(float lo, float hi) { unsigned r; asm volatile("s_nop 1\n\tv_cvt_pk_bf16_f32 %0, %1, %2\n\ts_nop 0" : "=v"(r) : "v"(lo), "v"(hi)); return r; }
__device__ __forceinline__ float bf2f(unsigned b) { return __uint_as_float(b << 16); }
__device__ __forceinline__ float bflo(unsigned w) { return __uint_as_float(w << 16); }
__device__ __forceinline__ float bfhi(unsigned w) { return __uint_as_float(w & 0xffff0000u); }
__device__ __forceinline__ float wave_sum(float v) {
#pragma unroll
    for (int o = 1; o < 64; o <<= 1) v += __shfl_xor(v, o);
    return v;
}
__device__ __forceinline__ float sigmoidf_(float x) { return __builtin_amdgcn_rcpf(1.0f + __expf(-x)); }
#define LDS_WAIT() asm volatile("s_waitcnt lgkmcnt(0)" ::: "memory")
__device__ __forceinline__ int lane_id() { int l; asm volatile("v_mbcnt_lo_u32_b32 %0, -1, 0\n\tv_mbcnt_hi_u32_b32 %0, -1, %0" : "=v"(l)); return l; }

namespace pg8 {
constexpr int BM = 256, BK = 64, HALF = 128, HTB = HALF * BK * 2, STAGE_BYTES = 8 * HTB, NXCD = 8, WGM = 8;
__host__ __device__ __forceinline__ int lds_byte(int r, int c) { const int st = (r >> 4) * 2 + (c >> 5), rr = r & 15, cc = c & 31, ob = rr * 64 + cc * 2; return st * 1024 + (ob ^ (((ob >> 9) & 1) << 5)); }
__host__ __device__ __forceinline__ void stage_rc(int b, int& R, int& C) { const int st = b / 1024, sb = b % 1024, swz = sb ^ (((sb >> 9) & 1) << 5); R = (st >> 1) * 16 + swz / 64; C = (st & 1) * 32 + (swz % 64) / 2; }
__host__ __device__ __forceinline__ int perm32(int rho) { const int n = rho >> 4, i = rho & 15; return 8 * (i >> 2) + 4 * n + (i & 3); }

struct Unit { int pm, pn, z; };
struct Gemm { const bf16_t* A; const bf16_t* Bt; int K; size_t zsA, zsB; int ld; };

struct Sched {
    int nM, nN, nwg, G, c, Z;
    __device__ void init(int M_, int N_, int G_, int c_, int Z_) { nM = M_ / BM; nN = N_ / BM; nwg = nM * nN; G = G_; c = c_; Z = Z_; }
    __device__ bool next(int i, Unit& u) const {
        int z = 0, ii = i;
        if (Z > 1) { z = i % Z; ii = i / Z; }
        const long L = (long)ii * G + c; if (L >= nwg) return false;
        int wgid = (int)L; { const int q = nwg / NXCD, r = nwg % NXCD, xcd = wgid % NXCD, off = wgid / NXCD; wgid = (xcd < r ? xcd * (q + 1) : r * (q + 1) + (xcd - r) * q) + off; }
        const int nig = WGM * nN, gid = wgid / nig, fm = gid * WGM, gsz = (nM - fm) < WGM ? (nM - fm) : WGM;
        u.pm = fm + ((wgid % nig) % gsz); u.pn = (wgid % nig) / gsz; u.z = z; return true;
    }
};

template <class Epi, class SchedT>
__device__ __forceinline__ void gemm_phase(LAS unsigned char* lds, const Gemm g, const SchedT& S, const Epi& E, const int wid) {
    const int lane = lane_id(), tid = wid * 64 + lane, wr = wid >> 2, wc = wid & 3, fr = lane & 15, fq = lane >> 4;
    const int K = g.K, nt = K / BK, ld = g.ld ? g.ld : g.K;
    unsigned voffA[2], voffB[2];
#pragma unroll
    for (int i = 0; i < 2; ++i) { int R, C; stage_rc(tid * 16 + i * 8192, R, C); const int Rb = (R & ~31) + perm32(R & 31);
        voffA[i] = (unsigned)(R * ld + C) * 2u; voffB[i] = (unsigned)(Rb * ld + C) * 2u; }
    const size_t kstep = (size_t)(BK * 2);
    const size_t hstep = (size_t)HALF * ld * 2;
    const size_t tstep = 2 * hstep;
    const unsigned ldsw = (unsigned)wid * 1024u;
    const int aoff = lds_byte(wr * 64 + fr, fq * 8), boff = lds_byte(wc * 32 + fr, fq * 8);
#define PG8_SA(b, h) (((b) * 2 + (h)) * HTB)
#define PG8_SB(b, h) ((4 + (b) * 2 + (h)) * HTB)
#define PG8_STAGE(bufoff, gbase, voff) do { _Pragma("unroll") for (int _i = 0; _i < 2; ++_i) \
        __builtin_amdgcn_global_load_lds((const unsigned*)((const char*)(gbase) + (voff)[_i]), (LAS unsigned*)(lds + (bufoff) + ldsw + _i * 8192), 16, 0, 0); } while (0)
#define PG8_LDA(dst, b, h) do { _Pragma("unroll") for (int m = 0; m < 4; ++m) _Pragma("unroll") for (int k = 0; k < 2; ++k) dst[m][k] = *(const LAS bf16x8*)(lds + PG8_SA(b, h) + aoff + m * 2048 + k * 1024); } while (0)
#define PG8_LDB(dst, b, h) do { _Pragma("unroll") for (int n = 0; n < 2; ++n) _Pragma("unroll") for (int k = 0; k < 2; ++k) dst[n][k] = *(const LAS bf16x8*)(lds + PG8_SB(b, h) + boff + n * 2048 + k * 1024); } while (0)
#define PG8_MMA(ai, bj, At, Bt) do { __builtin_amdgcn_s_setprio(1); _Pragma("unroll") for (int m = 0; m < 4; ++m) _Pragma("unroll") for (int n = 0; n < 2; ++n) _Pragma("unroll") for (int k = 0; k < 2; ++k) \
        acc[ai][bj][m][n] = __builtin_amdgcn_mfma_f32_16x16x32_bf16(Bt[n][k], At[m][k], acc[ai][bj][m][n], 0, 0, 0); __builtin_amdgcn_s_setprio(0); } while (0)
#define PG8_WAIT_V(n) asm volatile("s_waitcnt vmcnt(" #n ")" ::: "memory")
#define PG8_WAIT_L(n) asm volatile("s_waitcnt lgkmcnt(" #n ")" ::: "memory")
#define PG8_BAR __builtin_amdgcn_s_barrier()
#define PG8_SCHED __builtin_amdgcn_sched_barrier(0)
    Unit cur, nxt; int ui = 0;
    if (!S.next(0, cur)) return;
    f32x4 acc[2][2][4][2];
#pragma unroll
    for (int a = 0; a < 2; ++a)
#pragma unroll
        for (int b = 0; b < 2; ++b)
#pragma unroll
            for (int m = 0; m < 4; ++m)
#pragma unroll
                for (int n = 0; n < 2; ++n) acc[a][b][m][n] = (f32x4){0.f, 0.f, 0.f, 0.f};
    bf16x8 At[4][2], B0[2][2], B1[2][2];
    const char* cA = (const char*)g.A + (size_t)cur.z * g.zsA + (size_t)cur.pm * tstep; const char* cB = (const char*)g.Bt + (size_t)cur.z * g.zsB + (size_t)cur.pn * tstep;
    PG8_STAGE(PG8_SB(0, 0), cB, voffB); PG8_STAGE(PG8_SB(0, 1), cB + hstep, voffB); PG8_STAGE(PG8_SA(0, 0), cA, voffA); PG8_STAGE(PG8_SA(0, 1), cA + hstep, voffA);
    if (wr == 1) PG8_BAR;
    PG8_WAIT_V(2); PG8_BAR;
    PG8_STAGE(PG8_SB(1, 0), cB + kstep, voffB); PG8_STAGE(PG8_SA(1, 0), cA + kstep, voffA); PG8_STAGE(PG8_SB(1, 1), cB + hstep + kstep, voffB);
    PG8_WAIT_V(6); PG8_BAR;
    for (;;) {
        const bool has_next = S.next(ui + 1, nxt);
        const char* nA = has_next ? (const char*)g.A + (size_t)nxt.z * g.zsA + (size_t)nxt.pm * tstep : cA; const char* nB = has_next ? (const char*)g.Bt + (size_t)nxt.z * g.zsB + (size_t)nxt.pn * tstep : cB;
        for (int t = 0; t < nt; t += 2) {
            const bool last = (t == nt - 2);
            const char* a1 = cA + (size_t)(t + 1) * kstep;
            const char* a2 = last ? nA : cA + (size_t)(t + 2) * kstep; const char* b2 = last ? nB : cB + (size_t)(t + 2) * kstep;
            const char* a3 = a2 + kstep; const char* b3 = b2 + kstep;
            PG8_LDB(B0, 0, 0); PG8_LDB(B1, 0, 1); PG8_SCHED; PG8_LDA(At, 0, 0); PG8_STAGE(PG8_SA(1, 1), a1 + hstep, voffA);
            PG8_WAIT_V(8); PG8_WAIT_L(0); PG8_BAR; PG8_MMA(0, 0, At, B0); PG8_MMA(0, 1, At, B1); PG8_BAR; PG8_SCHED;
            PG8_LDA(At, 0, 1); PG8_STAGE(PG8_SB(0, 0), b2, voffB); PG8_STAGE(PG8_SB(0, 1), b2 + hstep, voffB); PG8_STAGE(PG8_SA(0, 0), a2, voffA);
            PG8_WAIT_V(8); PG8_WAIT_L(0); PG8_BAR; PG8_MMA(1, 0, At, B0); PG8_MMA(1, 1, At, B1); PG8_BAR; PG8_SCHED;
            PG8_LDB(B0, 1, 0); PG8_LDB(B1, 1, 1); PG8_SCHED; PG8_LDA(At, 1, 0); PG8_STAGE(PG8_SA(0, 1), a2 + hstep, voffA);
            PG8_WAIT_V(8); PG8_WAIT_L(0); PG8_BAR; PG8_MMA(0, 0, At, B0); PG8_MMA(0, 1, At, B1); PG8_BAR; PG8_SCHED;
            PG8_LDA(At, 1, 1); PG8_STAGE(PG8_SB(1, 0), b3, voffB); PG8_STAGE(PG8_SB(1, 1), b3 + hstep, voffB); PG8_STAGE(PG8_SA(1, 0), a3, voffA);
            PG8_WAIT_V(8); PG8_WAIT_L(0); PG8_BAR; PG8_MMA(1, 0, At, B0); PG8_MMA(1, 1, At, B1); PG8_BAR; PG8_SCHED;
        }
        if (wr == 0) PG8_BAR;
        E(acc, cur, wr, wc, fr, fq);
        if (!has_next) break;
#pragma unroll
        for (int a = 0; a < 2; ++a)
#pragma unroll
            for (int b = 0; b < 2; ++b)
#pragma unroll
                for (int m = 0; m < 4; ++m)
#pragma unroll
                    for (int n = 0; n < 2; ++n) acc[a][b][m][n] = (f32x4){0.f, 0.f, 0.f, 0.f};
        cur = nxt; cA = nA; cB = nB; ++ui;
        if (wr == 1) PG8_BAR;
    }
    PG8_WAIT_V(0);
    PG8_BAR;
#undef PG8_SA
#undef PG8_SB
#undef PG8_STAGE
#undef PG8_LDA
#undef PG8_LDB
#undef PG8_MMA
#undef PG8_WAIT_V
#undef PG8_WAIT_L
#undef PG8_BAR
#undef PG8_SCHED
}

struct SchedSplit {
    int nN, S, G, c;
    __device__ bool next(int i, Unit& u) const { const int L = i * G + c; if (L >= nN * S) return false; u.pm = 0; u.pn = L % nN; u.z = L / nN; return true; }
};
typedef const f32x4 (&AccRef)[2][2][4][2];
__device__ __forceinline__ u32x4 pack8(const f32x4 a, const f32x4 b) { u32x4 w; w.x = cvt_pk_bf16(a[0], a[1]); w.y = cvt_pk_bf16(a[2], a[3]); w.z = cvt_pk_bf16(b[0], b[1]); w.w = cvt_pk_bf16(b[2], b[3]); return w; }

struct EpiSwiglu {
    bf16_t* ACT;
    __device__ __forceinline__ void operator()(AccRef acc, const Unit& u, int wr, int wc, int fr, int fq) const {
        const int row0 = u.pm * BM + wr * 64 + fr, col = u.pn * 128 + wc * 32 + 8 * fq;
#pragma unroll
        for (int ai = 0; ai < 2; ++ai)
#pragma unroll
            for (int m = 0; m < 4; ++m) {
                f32x4 r0, r1;
#pragma unroll
                for (int j = 0; j < 4; ++j) { const float g0 = acc[ai][0][m][0][j], g1 = acc[ai][0][m][1][j];
                    r0[j] = g0 * sigmoidf_(g0) * acc[ai][1][m][0][j]; r1[j] = g1 * sigmoidf_(g1) * acc[ai][1][m][1][j]; }
                *(u32x4*)(ACT + (size_t)(row0 + ai * HALF + m * 16) * FF + col) = pack8(r0, r1);
            }
    }
};
struct EpiDown {
    bf16_t* Y; float* RSQ;
    __device__ __forceinline__ void operator()(AccRef acc, const Unit& u, int wr, int wc, int fr, int fq) const {
        const int row0 = u.pm * BM + wr * 64 + fr, col = u.pn * BM + wc * 32 + 8 * fq;
#pragma unroll
        for (int ai = 0; ai < 2; ++ai)
#pragma unroll
            for (int m = 0; m < 4; ++m) { const int row = row0 + ai * HALF + m * 16; float s = 0.f;
#pragma unroll
                for (int bj = 0; bj < 2; ++bj) { const f32x4 a = acc[ai][bj][m][0], b = acc[ai][bj][m][1];
                    s += (a[0] * a[0] + a[1] * a[1]) + (a[2] * a[2] + a[3] * a[3]) + (b[0] * b[0] + b[1] * b[1]) + (b[2] * b[2] + b[3] * b[3]);
                    *(u32x4*)(Y + (size_t)row * D + col + bj * HALF) = pack8(a, b); }
                s += __shfl_xor(s, 16); s += __shfl_xor(s, 32);
                if (fq == 0) RSQ[(size_t)row * 32 + u.pn * 4 + wc] = s; }
    }
};
struct EpiSplitAcc {
    float* ZS;
    __device__ __forceinline__ void operator()(AccRef acc, const Unit& u, int wr, int wc, int fr, int fq) const {
        const int row0 = wr * 64 + fr, col = u.pn * BM + wc * 32 + 8 * fq;
#pragma unroll
        for (int ai = 0; ai < 2; ++ai)
#pragma unroll
            for (int m = 0; m < 4; ++m) { float* rp = ZS + (size_t)(row0 + ai * HALF + m * 16) * D + col;
#pragma unroll
                for (int bj = 0; bj < 2; ++bj)
#pragma unroll
                    for (int n = 0; n < 2; ++n) *(f32x4*)(rp + (size_t)u.z * 256 * D + bj * HALF + 4 * n) = acc[ai][bj][m][n]; }
    }
};
struct EpiWin {
    bf16_t* PROJ; float* out;
    __device__ __forceinline__ void operator()(AccRef acc, const Unit& u, int wr, int wc, int fr, int fq) const {
        const int row0 = u.pm * BM + wr * 64 + fr, col = u.pn * BM + wc * 32 + 8 * fq;
        const bool kv = (u.pn >= 8 && u.pn < 16), isk = u.pn < 12, samp = (u.pm == 128), tailp = (!samp && (u.pm & 15) >= 14);
        const int kcol0 = col - (isk ? 2048 : 3072);
#pragma unroll
        for (int ai = 0; ai < 2; ++ai)
#pragma unroll
            for (int m = 0; m < 4; ++m) { const int row = row0 + ai * HALF + m * 16;
#pragma unroll
                for (int bj = 0; bj < 2; ++bj) { const f32x4 a = acc[ai][bj][m][0], b = acc[ai][bj][m][1];
                    *(u32x4*)(PROJ + (size_t)row * NIN5 + col + bj * HALF) = pack8(a, b);
                    if (kv && (samp || tailp)) {
                        float* dst;
                        if (samp) dst = out + (isk ? O_ATTK_S : O_ATTV_S) + (size_t)(row - MP) * 1024 + kcol0 + bj * HALF;
                        else { const int bb = row >> 12, t = row & 4095; dst = out + (isk ? O_ATTK_P : O_ATTV_P) + (size_t)(bb * 512 + t - 3584) * 1024 + kcol0 + bj * HALF; }
                        *(f32x4*)dst = a; *(f32x4*)(dst + 4) = b; } } }
    }
};
struct EpiMemKV {
    bf16_t* MKV; float* out;
    __device__ __forceinline__ void operator()(AccRef acc, const Unit& u, int wr, int wc, int fr, int fq) const {
        const int row0 = u.pm * BM + wr * 64 + fr, col = u.pn * BM + wc * 32 + 8 * fq;
        const bool isk = u.pn < 4; float* ob = out + (isk ? O_MEMK_P : O_MEMV_P) + (col - (isk ? 0 : 1024));
#pragma unroll
        for (int ai = 0; ai < 2; ++ai)
#pragma unroll
            for (int m = 0; m < 4; ++m) { const int row = row0 + ai * HALF + m * 16;
#pragma unroll
                for (int bj = 0; bj < 2; ++bj) { const f32x4 a = acc[ai][bj][m][0], b = acc[ai][bj][m][1];
                    *(u32x4*)(MKV + (size_t)row * 2048 + col + bj * HALF) = pack8(a, b);
                    float* dst = ob + (size_t)row * 1024 + bj * HALF; *(f32x4*)dst = a; *(f32x4*)(dst + 4) = b; } }
    }
};
struct EpiGate {
    bf16_t* G;
    __device__ __forceinline__ void operator()(AccRef acc, const Unit& u, int wr, int wc, int fr, int fq) const {
        const int row0 = u.pm * BM + wr * 64 + fr, col = u.pn * BM + wc * 32 + 8 * fq;
#pragma unroll
        for (int ai = 0; ai < 2; ++ai)
#pragma unroll
            for (int m = 0; m < 4; ++m) { const int row = row0 + ai * HALF + m * 16;
#pragma unroll
                for (int bj = 0; bj < 2; ++bj) { const f32x4 a = acc[ai][bj][m][0], b = acc[ai][bj][m][1];
                    *(u32x4*)(G + (size_t)row * NGATE + col + bj * HALF) = pack8(a, b); } }
    }
};
__device__ __forceinline__ void unpack8(const u32x4 w, f32x4& a, f32x4& b) { a[0] = bflo(w.x); a[1] = bfhi(w.x); a[2] = bflo(w.y); a[3] = bfhi(w.y); b[0] = bflo(w.z); b[1] = bfhi(w.z); b[2] = bflo(w.w); b[3] = bfhi(w.w); }
struct EpiGlu {
    const bf16_t* YS; const float* bias; bf16_t* OS;
    __device__ __forceinline__ void operator()(AccRef acc, const Unit& u, int wr, int wc, int fr, int fq) const {
        const int row0 = u.pm * BM + wr * 64 + fr, col = u.pn * BM + wc * 32 + 8 * fq;
#pragma unroll
        for (int ai = 0; ai < 2; ++ai)
#pragma unroll
            for (int m = 0; m < 4; ++m) { const int row = row0 + ai * HALF + m * 16;
#pragma unroll
                for (int bj = 0; bj < 2; ++bj) { f32x4 a = acc[ai][bj][m][0], b = acc[ai][bj][m][1];
                    const size_t off = (size_t)row * 1024 + col + bj * HALF;
                    const f32x4 b0 = *(const f32x4*)(bias + col + bj * HALF), b1 = *(const f32x4*)(bias + col + bj * HALF + 4);
                    f32x4 y0, y1; unpack8(__builtin_nontemporal_load((const u32x4*)(YS + off)), y0, y1);
#pragma unroll
                    for (int j = 0; j < 4; ++j) { a[j] = y0[j] * sigmoidf_(a[j] + b0[j]); b[j] = y1[j] * sigmoidf_(b[j] + b1[j]); }
                    *(u32x4*)(OS + off) = pack8(a, b); } }
    }
};
struct EpiBranch {
    const bf16_t* G; bf16_t* MG;
    __device__ __forceinline__ void operator()(AccRef acc, const Unit& u, int wr, int wc, int fr, int fq) const {
        const int row0 = u.pm * BM + wr * 64 + fr, col = u.pn * BM + wc * 32 + 8 * fq;
#pragma unroll
        for (int ai = 0; ai < 2; ++ai)
#pragma unroll
            for (int m = 0; m < 4; ++m) { const int row = row0 + ai * HALF + m * 16;
#pragma unroll
                for (int bj = 0; bj < 2; ++bj) { f32x4 a = acc[ai][bj][m][0], b = acc[ai][bj][m][1];
                    f32x4 g0, g1; unpack8(__builtin_nontemporal_load((const u32x4*)(G + (size_t)row * NGATE + u.z * 2048 + col + bj * HALF)), g0, g1);
                    bf16_t* mp = MG + (size_t)row * D + col + bj * HALF;
#pragma unroll
                    for (int j = 0; j < 4; ++j) { a[j] = a[j] * sigmoidf_(g0[j]); b[j] = b[j] * sigmoidf_(g1[j]); }
                    if (u.z > 0) { f32x4 o0, o1; unpack8(*(const volatile u32x4*)mp, o0, o1); a = a + o0; b = b + o1; }
                    *(volatile u32x4*)mp = pack8(a, b); } }
    }
};
}

struct Params { const float* in[40]; float* out; unsigned char* ws; int ph_lo, ph_hi; };
enum { I_XP = 0, I_XS, I_MEMP, I_CAK, I_CAV, I_CMK, I_CMV, I_SRE, I_SIM, I_F1PRE, I_F1POST, I_F1G, I_F1U, I_F1D, I_MIXPRE, I_MIXPOST, I_WIN,
       I_SARE, I_SAIM, I_SLDT, I_SBRE, I_SBIM, I_SCRE, I_SCIM, I_SD, I_SWGLU, I_SBGLU, I_RELB, I_MEMNORM, I_WMK, I_WMV, I_WBS, I_WBA, I_WBM, I_WOUT,
       I_F2PRE, I_F2POST, I_F2G, I_F2U, I_F2D };

__device__ __forceinline__ void tr_item(const float* W, int K, int N, bf16_t* WT, int row_off, int inter, LAS float* scr, int item, int lane) {
    const int nblk = N / 32, kb = item / nblk, nb = item % nblk, k0 = 64 * kb, n0 = 32 * nb;
#pragma unroll 8
    for (int i = 0; i < 32; ++i) { const int kk = 2 * i + (lane >> 5); scr[kk * 33 + (lane & 31)] = __builtin_nontemporal_load(W + (size_t)(k0 + kk) * N + n0 + (lane & 31)); }
    LDS_WAIT();
    const int c = lane & 7;
#pragma unroll
    for (int j = 0; j < 4; ++j) { const int n = (lane >> 3) + 8 * j; const LAS float* s = scr + (8 * c) * 33 + n;
        u32x4 o; o.x = cvt_pk_bf16(s[0 * 33], s[1 * 33]); o.y = cvt_pk_bf16(s[2 * 33], s[3 * 33]); o.z = cvt_pk_bf16(s[4 * 33], s[5 * 33]); o.w = cvt_pk_bf16(s[6 * 33], s[7 * 33]);
        const int col = n0 + n; const int drow = inter ? (((col >> 7) << 8) + (col & 127) + row_off) : (row_off + col);
        *(u32x4*)(WT + (size_t)drow * K + k0 + 8 * c) = o; }
    LDS_WAIT();
}
__device__ __forceinline__ void rms_row_to_bf16(const float* xrow, const float* gain, bf16_t* orow, int lane) {
    f32x4 v[8]; float s = 0.f;
#pragma unroll
    for (int j = 0; j < 8; ++j) { v[j] = __builtin_nontemporal_load((const f32x4*)(xrow + 4 * lane + 256 * j)); s += (v[j][0] * v[j][0] + v[j][1] * v[j][1]) + (v[j][2] * v[j][2] + v[j][3] * v[j][3]); }
    const float rs = rsqrtf(wave_sum(s) * (1.0f / D) + EPS);
#pragma unroll
    for (int j = 0; j < 8; ++j) { const f32x4 gg = *(const f32x4*)(gain + 4 * lane + 256 * j);
        u32x2 w; w.x = cvt_pk_bf16(v[j][0] * rs * gg[0], v[j][1] * rs * gg[1]); w.y = cvt_pk_bf16(v[j][2] * rs * gg[2], v[j][3] * rs * gg[3]);
        *(u32x2*)(orow + 4 * lane + 256 * j) = w; }
}
__device__ __forceinline__ void cvt_copy(const float* src, bf16_t* dst, size_t n, int gw, int NGW, int lane) {
    for (size_t i = ((size_t)gw * 64 + lane) * 8; i < n; i += (size_t)NGW * 512) {
        const f32x4 a = __builtin_nontemporal_load((const f32x4*)(src + i)), b = __builtin_nontemporal_load((const f32x4*)(src + i + 4));
        *(u32x4*)(dst + i) = pg8::pack8(a, b); }
}


__device__ __forceinline__ int vpos_of(int key) { return (key >> 5) * 32 + ((key >> 2) & 3) * 8 + ((key >> 4) & 1) * 4 + (key & 3); }
template <class T> __device__ __forceinline__ void mvt_build(const T* src, int spitch, int scol0, bf16_t* dst, int nb, size_t gtid, size_t nthr) {
    for (size_t idx = gtid; idx < (size_t)nb * 4096; idx += nthr) {
        const int d = (int)(idx & 63), dc = (int)((idx >> 6) & 3), kb = (int)((idx >> 8) & 3), h = (int)((idx >> 10) & 3), b = (int)(idx >> 12);
        const T* sp = src + ((size_t)b * 256 + kb * 64) * spitch + scol0 + h * 256 + dc * 64 + d;
        bf16_t* dp = dst + ((((size_t)(b * 4 + h) * 4 + kb) * 4 + dc) * 64 + d) * 64;
#pragma unroll
        for (int c = 0; c < 8; ++c) { const int t = c >> 2, g = c & 3; float v[8];
#pragma unroll
            for (int i = 0; i < 8; ++i) { const int key = 32 * t + 16 * (i >> 2) + 4 * g + (i & 3);
                if constexpr (sizeof(T) == 4) v[i] = (float)sp[(size_t)key * spitch]; else v[i] = bf2f(sp[(size_t)key * spitch]); }
            u32x4 w; w.x = cvt_pk_bf16(v[0], v[1]); w.y = cvt_pk_bf16(v[2], v[3]); w.z = cvt_pk_bf16(v[4], v[5]); w.w = cvt_pk_bf16(v[6], v[7]);
            *(u32x4*)(dp + 8 * c) = w; }
    }
}

template <int MODE>
__device__ __forceinline__ void ew_phase(const Params& p, const float* gpost, const float* gpre, int gw, int NGW, int lane, int nsplit) {
    float* H = p.out; const bf16_t* Y = (const bf16_t*)(p.ws + WS_YO); const float* RSQ = (const float*)(p.ws + WS_RSQ); bf16_t* U = (bf16_t*)(p.ws + WS_U);
    const float c = (MODE == 2) ? 1.0f : 0.5f;
    for (int row = gw; row < M; row += NGW) {
        const float* hin = (MODE == 1) ? (row < MP ? p.in[I_XP] + (size_t)row * D : p.in[I_XS] + (size_t)(row - MP) * D) : H + (size_t)row * D;
        f32x4 yv[8]; float part = 0.f;
        if (row < MP) {
            part = lane < 32 ? __builtin_nontemporal_load(RSQ + (size_t)row * 32 + lane) : 0.f;
#pragma unroll
            for (int j = 0; j < 8; ++j) { const u32x2 yw = __builtin_nontemporal_load((const u32x2*)(Y + (size_t)row * D + 4 * lane + 256 * j)); yv[j] = (f32x4){bflo(yw.x), bfhi(yw.x), bflo(yw.y), bfhi(yw.y)}; }
        } else {
            const float* zr = (const float*)(p.ws + WS_ZS) + (size_t)(row - MP) * D;
#pragma unroll
            for (int j = 0; j < 8; ++j) { f32x4 a = (f32x4){0.f, 0.f, 0.f, 0.f};
                for (int sl = 0; sl < nsplit; ++sl) { const u32x4 t = __builtin_nontemporal_load((const u32x4*)(zr + (size_t)sl * 256 * D + 4 * lane + 256 * j)); a[0] += __uint_as_float(t.x); a[1] += __uint_as_float(t.y); a[2] += __uint_as_float(t.z); a[3] += __uint_as_float(t.w); }
                yv[j] = a; part += (a[0] * a[0] + a[1] * a[1]) + (a[2] * a[2] + a[3] * a[3]); }
        }
        const float rs = rsqrtf(wave_sum(part) * (1.0f / D) + EPS) * c;
        f32x4 hv[8]; float ss = 0.f;
#pragma unroll
        for (int j = 0; j < 8; ++j) { const int col = 4 * lane + 256 * j;
            const f32x4 h4 = __builtin_nontemporal_load((const f32x4*)(hin + col)); const f32x4 g4 = *(const f32x4*)(gpost + col);
            f32x4 hn; hn[0] = h4[0] + yv[j][0] * rs * g4[0]; hn[1] = h4[1] + yv[j][1] * rs * g4[1]; hn[2] = h4[2] + yv[j][2] * rs * g4[2]; hn[3] = h4[3] + yv[j][3] * rs * g4[3];
            hv[j] = hn; ss += (hn[0] * hn[0] + hn[1] * hn[1]) + (hn[2] * hn[2] + hn[3] * hn[3]);
            __builtin_nontemporal_store(hn, (f32x4*)(H + (size_t)row * D + col)); }
        if (MODE != 3) {
            const float rs2 = rsqrtf(wave_sum(ss) * (1.0f / D) + EPS);
#pragma unroll
            for (int j = 0; j < 8; ++j) { const int col = 4 * lane + 256 * j; const f32x4 gg = *(const f32x4*)(gpre + col);
                u32x2 w; w.x = cvt_pk_bf16(hv[j][0] * rs2 * gg[0], hv[j][1] * rs2 * gg[1]); w.y = cvt_pk_bf16(hv[j][2] * rs2 * gg[2], hv[j][3] * rs2 * gg[3]);
                *(u32x2*)(U + (size_t)row * D + col) = w; }
        }
    }
}

template <int NQ, int HD, bool BIAS, bool VTG>
__device__ __forceinline__ void attn_item(const bf16_t* Q, int qpitch, const bf16_t* K0, const bf16_t* V0, size_t kbstride, int pitch, int nreg,
                                          const bf16_t* Ks, const bf16_t* Vs, int pitch_s, int nvalid_s, bool has_s,
                                          int qpos0, int kpos_base, float scale, const float* bias_g, bf16_t* O, int opitch, LAS unsigned char* wl, int lane, const bf16_t* VT = nullptr) {
    const int fr = lane & 15, g = lane >> 4;
    LAS float* bl = (LAS float*)(wl + 9216);
    LAS bf16_t* vt = (LAS bf16_t*)wl;
    if (BIAS) { for (int i = lane; i < 257; i += 64) bl[i] = bias_g[i]; }
    bf16x8 qf[NQ][HD / 32];
#pragma unroll
    for (int nq = 0; nq < NQ; ++nq)
#pragma unroll
        for (int kd = 0; kd < HD / 32; ++kd) qf[nq][kd] = *(const bf16x8*)(Q + (size_t)(16 * nq + fr) * qpitch + 32 * kd + 8 * g);
    float mrow[NQ], lrow[NQ]; f32x4 o[HD / 16][NQ];
#pragma unroll
    for (int nq = 0; nq < NQ; ++nq) { mrow[nq] = -1e30f; lrow[nq] = 0.f;
#pragma unroll
        for (int md = 0; md < HD / 16; ++md) o[md][nq] = (f32x4){0.f, 0.f, 0.f, 0.f}; }
    LDS_WAIT();
    const int nkb = nreg + (has_s ? 1 : 0);
    const int vpos = (lane >> 5) * 32 + ((lane >> 2) & 3) * 8 + ((lane >> 4) & 1) * 4 + (lane & 3);
    for (int kb = 0; kb < nkb; ++kb) {
        const bool sp = kb >= nreg;
        const bf16_t* Kp = sp ? Ks : K0 + (size_t)kb * kbstride; const bf16_t* Vp = sp ? Vs : V0 + (size_t)kb * kbstride;
        const int pt = sp ? pitch_s : pitch, nv = sp ? nvalid_s : 64;
        f32x4 st[4][NQ];
#pragma unroll
        for (int mk = 0; mk < 4; ++mk) {
#pragma unroll
            for (int nq = 0; nq < NQ; ++nq) st[mk][nq] = (f32x4){0.f, 0.f, 0.f, 0.f};
            const bool kok = (16 * mk + fr) < nv;
#pragma unroll
            for (int kd = 0; kd < HD / 32; ++kd) {
                bf16x8 kf = (bf16x8){0, 0, 0, 0, 0, 0, 0, 0};
                if (kok) kf = *(const bf16x8*)(Kp + (size_t)(16 * mk + fr) * pt + 32 * kd + 8 * g);
#pragma unroll
                for (int nq = 0; nq < NQ; ++nq) st[mk][nq] = __builtin_amdgcn_mfma_f32_16x16x32_bf16(kf, qf[nq][kd], st[mk][nq], 0, 0, 0);
            }
        }
        __builtin_amdgcn_sched_barrier(0); asm volatile("s_nop 15" ::: "memory"); __builtin_amdgcn_sched_barrier(0);
        constexpr int NPRE = (NQ == 4) ? 4 : 8;
        u32x4 vpre[8];
        if (!VTG && HD == 64) { const bool kvok0 = lane < nv; const bf16_t* vrow0 = Vp + (size_t)lane * pt;
#pragma unroll
            for (int cch = 0; cch < NPRE; ++cch) { vpre[cch] = (u32x4){0u, 0u, 0u, 0u}; if (kvok0) vpre[cch] = *(const u32x4*)(vrow0 + 8 * cch); } }
        const bool farb = BIAS && (qpos0 - (kpos_base + 64 * kb + 63) >= 128);
        const float bfar = BIAS ? bl[256] : 0.f;
        bf16x8 pb[2][NQ];
#pragma unroll
        for (int nq = 0; nq < NQ; ++nq) {
            const int qpos = qpos0 + 16 * nq + fr;
            float mx = -1e30f;
#pragma unroll
            for (int mk = 0; mk < 4; ++mk)
#pragma unroll
                for (int j = 0; j < 4; ++j) { const int key = 16 * mk + 4 * g + j; float s = st[mk][nq][j] * scale;
                    if (BIAS) { if (farb) s += bfar; else { int dd = qpos - (kpos_base + 64 * kb + key); dd = dd < -128 ? -128 : (dd > 128 ? 128 : dd); s += bl[dd + 128]; } }
                    if (key >= nv) s = -1e30f;
                    st[mk][nq][j] = s; mx = fmaxf(mx, s); }
            mx = fmaxf(mx, __shfl_xor(mx, 16)); mx = fmaxf(mx, __shfl_xor(mx, 32));
            const float mnew = fmaxf(mrow[nq], mx), alpha = __expf(mrow[nq] - mnew);
            float ps = 0.f;
#pragma unroll
            for (int mk = 0; mk < 4; ++mk)
#pragma unroll
                for (int j = 0; j < 4; ++j) { const float pv = __expf(st[mk][nq][j] - mnew); st[mk][nq][j] = pv; ps += pv; }
            ps += __shfl_xor(ps, 16); ps += __shfl_xor(ps, 32);
            lrow[nq] = lrow[nq] * alpha + ps; mrow[nq] = mnew;
#pragma unroll
            for (int md = 0; md < HD / 16; ++md) o[md][nq] = o[md][nq] * alpha;
#pragma unroll
            for (int t = 0; t < 2; ++t) { u32x4 w;
                w.x = cvt_pk_bf16(st[2 * t][nq][0], st[2 * t][nq][1]); w.y = cvt_pk_bf16(st[2 * t][nq][2], st[2 * t][nq][3]);
                w.z = cvt_pk_bf16(st[2 * t + 1][nq][0], st[2 * t + 1][nq][1]); w.w = cvt_pk_bf16(st[2 * t + 1][nq][2], st[2 * t + 1][nq][3]);
                pb[t][nq] = __builtin_bit_cast(bf16x8, w); }
        }
#pragma unroll
        for (int dc = 0; dc < HD / 64; ++dc) {
            if (VTG) {
                const bf16_t* vtile = VT + (size_t)(kb * (HD / 64) + dc) * 4096;
#pragma unroll
                for (int md = 0; md < 4; ++md)
#pragma unroll
                    for (int t = 0; t < 2; ++t) { const bf16x8 va = *(const bf16x8*)(vtile + (16 * md + fr) * 64 + (t * 4 + g) * 8);
#pragma unroll
                        for (int nq = 0; nq < NQ; ++nq) o[4 * dc + md][nq] = __builtin_amdgcn_mfma_f32_16x16x32_bf16(va, pb[t][nq], o[4 * dc + md][nq], 0, 0, 0); }
                asm volatile("" ::: "memory");
                continue;
            }
            const bool kvok = lane < nv;
            const bf16_t* vrow = Vp + (size_t)lane * pt + 64 * dc;
#pragma unroll
            for (int cch = 0; cch < 8; ++cch) {
                u32x4 vv = (u32x4){0u, 0u, 0u, 0u};
                if (HD == 64 && cch < NPRE) vv = vpre[cch]; else if (kvok) vv = *(const u32x4*)(vrow + 8 * cch);
                vt[(8 * cch + 0) * 72 + vpos] = (bf16_t)(vv.x & 0xffffu); vt[(8 * cch + 1) * 72 + vpos] = (bf16_t)(vv.x >> 16);
                vt[(8 * cch + 2) * 72 + vpos] = (bf16_t)(vv.y & 0xffffu); vt[(8 * cch + 3) * 72 + vpos] = (bf16_t)(vv.y >> 16);
                vt[(8 * cch + 4) * 72 + vpos] = (bf16_t)(vv.z & 0xffffu); vt[(8 * cch + 5) * 72 + vpos] = (bf16_t)(vv.z >> 16);
                vt[(8 * cch + 6) * 72 + vpos] = (bf16_t)(vv.w & 0xffffu); vt[(8 * cch + 7) * 72 + vpos] = (bf16_t)(vv.w >> 16);
            }
            LDS_WAIT();
#pragma unroll
            for (int md = 0; md < 4; ++md)
#pragma unroll
                for (int t = 0; t < 2; ++t) { const bf16x8 va = *(const LAS bf16x8*)(wl + (16 * md + fr) * 144 + (t * 4 + g) * 16);
#pragma unroll
                    for (int nq = 0; nq < NQ; ++nq) o[4 * dc + md][nq] = __builtin_amdgcn_mfma_f32_16x16x32_bf16(va, pb[t][nq], o[4 * dc + md][nq], 0, 0, 0); }
            LDS_WAIT();
        }
    }
    __builtin_amdgcn_sched_barrier(0); asm volatile("s_nop 15" ::: "memory"); __builtin_amdgcn_sched_barrier(0);
#pragma unroll
    for (int nq = 0; nq < NQ; ++nq) { const float inv = 1.0f / lrow[nq];
#pragma unroll
        for (int md = 0; md < HD / 16; ++md) { const f32x4 v = o[md][nq] * inv; u32x2 w; w.x = cvt_pk_bf16(v[0], v[1]); w.y = cvt_pk_bf16(v[2], v[3]);
            *(u32x2*)(O + (size_t)(16 * nq + fr) * opitch + 16 * md + 4 * g) = w; } }
}

__device__ __forceinline__ float gelu_tanh(float x) { const float z = 0.7978845608028654f * (x + 0.044715f * x * x * x); const float e = __expf(2.0f * z); return 0.5f * x * (2.0f - 2.0f * __builtin_amdgcn_rcpf(1.0f + e)); }
template <bool FULL>
__device__ __forceinline__ void ssm_run(const Params& p, int gi, size_t row0, int nsub, float& s_re, float& s_im, LAS unsigned char* wl, int lane) {
    const int fr = lane & 15, g = lane >> 4;
    const bf16_t* PROJ = (const bf16_t*)(p.ws + WS_BIG); bf16_t* YS = (bf16_t*)(p.ws + WS_YS);
    const float* SAB = (const float*)(p.ws + WS_SAB); const bf16_t* SBB = (const bf16_t*)(p.ws + WS_SBB); const bf16_t* SCM = (const bf16_t*)(p.ws + WS_SCM);
    const f32x4 ab = *(const f32x4*)(SAB + (size_t)(gi * 64 + lane) * 4);
    const float a_re = ab[0], a_im = ab[1];
    bf16x4 bbf[8];
#pragma unroll
    for (int t = 0; t < 8; ++t) bbf[t] = *(const bf16x4*)(SBB + (size_t)(gi * 128 + 16 * t + fr) * 16 + 4 * g);
    bf16x8 cmf[4]; float dval = 0.f;
    if (FULL) {
#pragma unroll
        for (int kk = 0; kk < 4; ++kk) cmf[kk] = *(const bf16x8*)(SCM + (size_t)(gi * 16 + fr) * 128 + 32 * kk + 8 * g);
        dval = p.in[I_SD][gi * 16 + fr];
    }
    LAS float* BUl = (LAS float*)wl;
    LAS bf16_t* Sl = (LAS bf16_t*)(wl + 8448);
    bf16x4 uf_nx = *(const bf16x4*)(PROJ + (row0 + fr) * NIN5 + gi * 16 + 4 * g);
    for (int sc = 0; sc < nsub; ++sc) {
        const size_t t0 = row0 + 16 * sc;
        const bf16x4 uf = uf_nx;
        if (sc + 1 < nsub) uf_nx = *(const bf16x4*)(PROJ + (t0 + 16 + fr) * NIN5 + gi * 16 + 4 * g);
        bf16_t upre[4];
        if (FULL) {
#pragma unroll
            for (int j = 0; j < 4; ++j) upre[j] = PROJ[(t0 + 4 * g + j) * NIN5 + gi * 16 + fr];
        }
        f32x4 bu[8];
#pragma unroll
        for (int t = 0; t < 8; ++t) bu[t] = __builtin_amdgcn_mfma_f32_16x16x16bf16_1k(bbf[t], uf, (f32x4){0.f, 0.f, 0.f, 0.f}, 0, 0, 0);
        __builtin_amdgcn_sched_barrier(0); asm volatile("s_nop 15\n\ts_nop 15" ::: "memory"); __builtin_amdgcn_sched_barrier(0);
#pragma unroll
        for (int t = 0; t < 8; ++t) *(LAS f32x4*)(BUl + fr * 132 + 16 * t + 4 * g) = bu[t];
        LDS_WAIT();
        float br[16], bi[16];
#pragma unroll
        for (int t = 0; t < 16; ++t) { br[t] = BUl[t * 132 + lane]; bi[t] = BUl[t * 132 + 64 + lane]; }
#pragma unroll
        for (int t = 0; t < 16; ++t) {
            const float nr = fmaf(a_re, s_re, fmaf(-a_im, s_im, br[t])), ni = fmaf(a_re, s_im, fmaf(a_im, s_re, bi[t]));
            s_re = nr; s_im = ni;
            if (FULL) { const unsigned w = cvt_pk_bf16(nr, ni); Sl[t * 136 + lane] = (bf16_t)(w & 0xffffu); Sl[t * 136 + 64 + lane] = (bf16_t)(w >> 16); }
        }
        if (FULL) {
            LDS_WAIT();
            f32x4 y = (f32x4){0.f, 0.f, 0.f, 0.f};
#pragma unroll
            for (int kk = 0; kk < 4; ++kk) { const bf16x8 sf = *(const LAS bf16x8*)(wl + 8448 + (fr * 136 + 32 * kk + 8 * g) * 2);
                y = __builtin_amdgcn_mfma_f32_16x16x32_bf16(sf, cmf[kk], y, 0, 0, 0); }
            __builtin_amdgcn_sched_barrier(0); asm volatile("s_nop 15\n\ts_nop 15" ::: "memory"); __builtin_amdgcn_sched_barrier(0);
#pragma unroll
            for (int j = 0; j < 4; ++j) { const size_t tok = t0 + 4 * g + j; const float uu = bf2f(upre[j]);
                const float yy = gelu_tanh(y[j] + dval * uu); YS[tok * 1024 + gi * 16 + fr] = (bf16_t)(cvt_pk_bf16(yy, 0.f) & 0xffffu); }
        }
        LDS_WAIT();
    }
}

#define XB_TMO      128
#define XB_XCNT(j)  (256  + 64 * (j))
#define XB_XSUB(j)  (1280 + 64 * (j))
#define XB_XGEN(j)  (2304 + 64 * (j))
#define XB_TOP      3328
#define XB_TOPGEN   3392
#define XCD_BAR_WORDS 3456
#define XB_SPIN_CAP (1u << 18)

__device__ __forceinline__ unsigned xb_ld(unsigned* p)              { return __hip_atomic_load(p, __ATOMIC_RELAXED, __HIP_MEMORY_SCOPE_AGENT); }
__device__ __forceinline__ unsigned xb_add(unsigned* p, unsigned v) { return __hip_atomic_fetch_add(p, v, __ATOMIC_RELAXED, __HIP_MEMORY_SCOPE_AGENT); }
__device__ __forceinline__ unsigned xb_xcc_id() { return (unsigned)__builtin_amdgcn_s_getreg((3 << 11) | 20) & 0xFu; }
#define XB_SPIN(cond, bar) do { unsigned _sp = 0; while (cond) { __builtin_amdgcn_s_sleep(1); \
    if ((++_sp & 255u) == 0u) { if (xb_ld(&(bar)[XB_TMO])) break; if (_sp > XB_SPIN_CAP) { atomicAdd(&(bar)[XB_TMO], 1u); break; } } } } while (0)

struct XcdBarrier {
    unsigned* bar; unsigned x;
    volatile LAS unsigned* st;
};

__device__ __forceinline__ XcdBarrier xcd_barrier_post(unsigned* bar, volatile LAS unsigned* st) {
    XcdBarrier b; b.bar = bar; b.x = xb_xcc_id(); b.st = st;
    if (threadIdx.x == 0) (void)xb_add(&bar[XB_XCNT(b.x)], 1u);
    return b;
}
__device__ __forceinline__ void xcd_barrier_complete(unsigned* bar, unsigned x, unsigned& nloc, unsigned& nx) {
    const unsigned G = gridDim.x * gridDim.y * gridDim.z;
    unsigned sum, cnt, mine, sp = 0u;
    for (;;) {
        sum = 0u; cnt = 0u; mine = 0u;
#pragma unroll
        for (unsigned j = 0; j < 16; ++j) { const unsigned c = xb_ld(&bar[XB_XCNT(j)]); sum += c; cnt += (c > 0u) ? 1u : 0u; mine = (j == x) ? c : mine; }
        if (sum == G) break;
        __builtin_amdgcn_s_sleep(1);
        if ((++sp & 255u) == 0u) { if (xb_ld(&bar[XB_TMO])) break; if (sp > XB_SPIN_CAP) { atomicAdd(&bar[XB_TMO], 1u); break; } }
    }
    nloc = mine > 0u ? mine : 1u; nx = cnt > 0u ? cnt : 1u;
}

__device__ __forceinline__ void xcd_barrier(const XcdBarrier& b) {
    asm volatile("s_waitcnt vmcnt(0)" ::: "memory");
    __syncthreads();
    if (threadIdx.x == 0) {
        unsigned* bar = b.bar;
        __builtin_amdgcn_s_waitcnt(0);
        unsigned nloc = b.st[0], nx = b.st[1];
        if (nloc == 0u) { xcd_barrier_complete(bar, b.x, nloc, nx); b.st[0] = nloc; b.st[1] = nx; }
        const unsigned old = xb_add(&bar[XB_XSUB(b.x)], 1u);
        const unsigned gen = old / nloc;
        if (old + 1u == (gen + 1u) * nloc) {
            __builtin_amdgcn_fence(__ATOMIC_RELEASE, "agent");
            asm volatile("s_waitcnt vmcnt(0)" ::: "memory");
            const unsigned og = xb_add(&bar[XB_TOP], 1u);
            const unsigned tg = og / nx;
            if (og + 1u == (tg + 1u) * nx) xb_add(&bar[XB_TOPGEN], 1u);
            else XB_SPIN(xb_ld(&bar[XB_TOPGEN]) == tg, bar);
            __builtin_amdgcn_fence(__ATOMIC_ACQUIRE, "agent");
            xb_add(&bar[XB_XGEN(b.x)], 1u);
            asm volatile("s_waitcnt vmcnt(0)" ::: "memory");
        } else {
            XB_SPIN(xb_ld(&bar[XB_XGEN(b.x)]) == gen, bar);
            __builtin_amdgcn_fence(__ATOMIC_ACQUIRE, "agent");
            asm volatile("s_waitcnt vmcnt(0)" ::: "memory");
        }
    }
    __syncthreads();
}


__global__ void __launch_bounds__(512, 2) mega_fwd(Params p) {
    extern __shared__ __attribute__((aligned(16))) unsigned char lds_raw[];
    cg::grid_group grid = cg::this_grid();
    LAS unsigned char* lds = (LAS unsigned char*)lds_raw;
    const int wave = __builtin_amdgcn_readfirstlane(threadIdx.x >> 6);
    const int G = gridDim.x, gw = blockIdx.x * 8 + wave, NGW = G * 8;
    LAS unsigned char* wl = lds + wave * WLDS;
    unsigned char* ws = p.ws;
    bf16_t* U = (bf16_t*)(ws + WS_U); bf16_t* BIG = (bf16_t*)(ws + WS_BIG); bf16_t* YO = (bf16_t*)(ws + WS_YO); float* RSQ = (float*)(ws + WS_RSQ);
    bf16_t* OS = YO; bf16_t* OA = YO + (size_t)M * 1024; bf16_t* OM = YO + (size_t)2 * M * 1024; bf16_t* YS = (bf16_t*)(ws + WS_YS);
    volatile LAS unsigned* bst = (volatile LAS unsigned*)(lds + 131072 + 64);
    if (threadIdx.x < 2) bst[threadIdx.x] = 0u;
    __syncthreads();
    const XcdBarrier xbar = xcd_barrier_post((unsigned*)ws, bst);
    const int lo = p.ph_lo, hi = p.ph_hi;
#define IN(k) (lo <= (k) && (k) < hi)
#define GSYNC() do { asm volatile("s_waitcnt vmcnt(0) lgkmcnt(0)" ::: "memory"); grid.sync(); __builtin_amdgcn_fence(__ATOMIC_ACQUIRE, "agent"); asm volatile("s_waitcnt vmcnt(0)" ::: "memory"); } while (0)
#define XSYNC() do { xcd_barrier(xbar); } while (0)
#define SEAM(k) do { if (IN(k) && IN((k) + 1)) { if ((k) == 0) GSYNC(); else XSYNC(); } } while (0)

    if (IN(0)) {
        const int lane = lane_id();
        LAS float* scr = (LAS float*)wl;
        struct TJ { int idx, K, N; size_t dst; int roff, inter; };
        const TJ jobs[15] = {
            {I_F1G, D, FF, WS_WGU1, 0, 1}, {I_F1U, D, FF, WS_WGU1, 128, 1}, {I_F1D, FF, D, WS_WD1, 0, 0}, {I_WIN, D, 11264, WS_WIN, 0, 0},
            {I_SWGLU, 1024, 1024, WS_WGLU, 0, 0}, {I_WMK, D, 1024, WS_WMKV, 0, 0}, {I_WMV, D, 1024, WS_WMKV, 1024, 0},
            {I_WBS, 1024, D, WS_WBR, 0, 0}, {I_WBA, 1024, D, WS_WBR + (size_t)2048 * 1024 * 2, 0, 0}, {I_WBM, 1024, D, WS_WBR + (size_t)2 * 2048 * 1024 * 2, 0, 0},
            {I_WOUT, D, D, WS_WOUT, 0, 0}, {I_F2G, D, FF, WS_WGU2, 0, 1}, {I_F2U, D, FF, WS_WGU2, 128, 1}, {I_F2D, FF, D, WS_WD2, 0, 0}, {0, 0, 0, 0, 0, 0}};
        int base = 0;
#pragma unroll
        for (int j = 0; j < 14; ++j) {
            const int K = jobs[j].K, N = jobs[j].N, ni = (K / 64) * (N / 32);
            int first = (gw - (base % NGW)); if (first < 0) first += NGW;
            for (int it = first; it < ni; it += NGW) tr_item(p.in[jobs[j].idx], K, N, (bf16_t*)(ws + jobs[j].dst), jobs[j].roff, jobs[j].inter, scr, it, lane);
            base += ni;
        }
        for (int row = gw; row < M; row += NGW)
            rms_row_to_bf16(row < MP ? p.in[I_XP] + (size_t)row * D : p.in[I_XS] + (size_t)(row - MP) * D, p.in[I_F1PRE], U + (size_t)row * D, lane);
        for (int row = gw; row < 2048; row += NGW) rms_row_to_bf16(p.in[I_MEMP] + (size_t)row * D, p.in[I_MEMNORM], (bf16_t*)(ws + WS_MN) + (size_t)row * D, lane);
        cvt_copy(p.in[I_CAK], (bf16_t*)(ws + WS_CK), (size_t)16 * 512 * 1024, gw, NGW, lane);
        cvt_copy(p.in[I_CAV], (bf16_t*)(ws + WS_CV), (size_t)16 * 512 * 1024, gw, NGW, lane);
        cvt_copy(p.in[I_CMK], (bf16_t*)(ws + WS_CMK), (size_t)16 * 256 * 1024, gw, NGW, lane);
        mvt_build<float>(p.in[I_CMV], 1024, 0, (bf16_t*)(ws + WS_CMVT), 16, (size_t)gw * 64 + lane, (size_t)NGW * 64);
        {
            const int idx = (NGW - 1 - gw) * 64 + lane;
            if (idx < 4096) {
                const int gi = idx >> 6, pp = idx & 63;
                const double are = (double)p.in[I_SARE][idx], aim = (double)p.in[I_SAIM][idx], dt = exp((double)p.in[I_SLDT][gi]);
                const double mag = exp(are * dt), abr = mag * cos(aim * dt), abi = mag * sin(aim * dt);
                const double magL = exp(are * dt * (double)SEG), alr = magL * cos(aim * dt * (double)SEG), ali = magL * sin(aim * dt * (double)SEG);
                const double den = are * are + aim * aim, nr = abr - 1.0, ni = abi;
                const double cr = (nr * are + ni * aim) / den, ci = (ni * are - nr * aim) / den;
                float* SAB = (float*)(ws + WS_SAB); bf16_t* SBB = (bf16_t*)(ws + WS_SBB); bf16_t* SCM = (bf16_t*)(ws + WS_SCM);
                *(f32x4*)(SAB + (size_t)idx * 4) = (f32x4){(float)abr, (float)abi, (float)alr, (float)ali};
#pragma unroll
                for (int h = 0; h < 16; h += 2) {
                    const double br0 = p.in[I_SBRE][(size_t)idx * 16 + h], bi0 = p.in[I_SBIM][(size_t)idx * 16 + h], br1 = p.in[I_SBRE][(size_t)idx * 16 + h + 1], bi1 = p.in[I_SBIM][(size_t)idx * 16 + h + 1];
                    *(unsigned*)(SBB + (size_t)(gi * 128 + pp) * 16 + h) = cvt_pk_bf16((float)(cr * br0 - ci * bi0), (float)(cr * br1 - ci * bi1));
                    *(unsigned*)(SBB + (size_t)(gi * 128 + 64 + pp) * 16 + h) = cvt_pk_bf16((float)(cr * bi0 + ci * br0), (float)(cr * bi1 + ci * br1));
                }
#pragma unroll
                for (int h = 0; h < 16; ++h) {
                    SCM[(size_t)(gi * 16 + h) * 128 + pp] = (bf16_t)(cvt_pk_bf16(p.in[I_SCRE][(size_t)(gi * 16 + h) * 64 + pp], 0.f) & 0xffffu);
                    SCM[(size_t)(gi * 16 + h) * 128 + 64 + pp] = (bf16_t)(cvt_pk_bf16(-p.in[I_SCIM][(size_t)(gi * 16 + h) * 64 + pp], 0.f) & 0xffffu);
                }
            }
        }
    }
    SEAM(0);
    if (IN(1)) {
        { pg8::Gemm g{U, (const bf16_t*)(ws + WS_WGU1), D, 0, 0}; pg8::Sched S; S.init(M, 2 * FF, G, blockIdx.x, 1); pg8::EpiSwiglu E{BIG}; pg8::gemm_phase(lds, g, S, E, wave); }
        { pg8::Gemm g{(const bf16_t*)(ws + WS_MN), (const bf16_t*)(ws + WS_WMKV), D, 0, 0}; pg8::Sched S; S.init(2048, 2048, G, (blockIdx.x + G - 44) % G, 1); pg8::EpiMemKV E{(bf16_t*)(ws + WS_MKV), p.out}; pg8::gemm_phase(lds, g, S, E, wave); }
    }
    SEAM(1);
    if (IN(2)) {
        { pg8::Gemm g{BIG, (const bf16_t*)(ws + WS_WD1), FF, 0, 0}; pg8::Sched S; S.init(MP, D, G, blockIdx.x, 1); pg8::EpiDown E{YO, RSQ}; pg8::gemm_phase(lds, g, S, E, wave); }
        { pg8::Gemm g{BIG + (size_t)MP * FF, (const bf16_t*)(ws + WS_WD1), 512, 1024, 1024, FF}; pg8::SchedSplit S{8, 11, G, (int)blockIdx.x}; pg8::EpiSplitAcc E{(float*)(ws + WS_ZS)}; pg8::gemm_phase(lds, g, S, E, wave); }
    }
    SEAM(2);
    if (IN(3)) { mvt_build<bf16_t>((const bf16_t*)(ws + WS_MKV), 2048, 1024, (bf16_t*)(ws + WS_MVT), 8, (size_t)gw * 64 + lane_id(), (size_t)NGW * 64);
        ew_phase<1>(p, p.in[I_F1POST], p.in[I_MIXPRE], gw, NGW, lane_id(), 11); }
    SEAM(3);
    if (IN(4)) { pg8::Gemm g{U, (const bf16_t*)(ws + WS_WIN), D, 0, 0}; pg8::Sched S; S.init(M, NIN5, G, blockIdx.x, 1); pg8::EpiWin E{BIG, p.out}; pg8::gemm_phase(lds, g, S, E, wave); }
    SEAM(4);
    if (IN(5)) {
        const bf16_t* PROJ = BIG;
        constexpr int N_SA = 8 * 64 * (NSEG - 1), N_BP = 8 * 64 * 16, N_MP = 8 * 256 * 4, N_BS = 256, N_MSs = 64;
        {
            const int lane = lane_id();
            const bool xmap = (G % 8 == 0);
            const int wxs = xmap ? (G / 8) * 8 : NGW, wx0 = xmap ? (int)(blockIdx.x >> 3) * 8 + wave : gw;
            for (int r0 = wx0; r0 < (xmap ? 1024 : N_BP); r0 += wxs) {
                const int r = xmap ? ((int)(blockIdx.x & 7) << 10) + r0 : r0;
                const int h = r & 15, c = (r >> 4) & 63, b = r >> 10;
                const int c0 = c >= 8 ? c - 8 : 0; const size_t qrow = (size_t)b * TP + c * 64, krow = (size_t)b * TP + c0 * 64;
                attn_item<4, 64, true, false>(PROJ + qrow * NIN5 + 1024 + h * 64, NIN5, PROJ + krow * NIN5 + 2048 + h * 64, PROJ + krow * NIN5 + 3072 + h * 64, (size_t)64 * NIN5, NIN5, c - c0 + 1,
                                       nullptr, nullptr, 0, 0, false, c * 64, c0 * 64, 0.125f, p.in[I_RELB] + h * 257, OA + qrow * 1024 + h * 64, 1024, wl, lane);
            }
        }
        {
            const int lane = lane_id();
            for (int r = (gw + NGW - 512) % NGW; r < N_SA; r += NGW) {
                const int gi = r & 63, rest = r >> 6, seg = rest % (NSEG - 1), b = rest / (NSEG - 1), bg = b * 64 + gi;
                float s_re = 0.f, s_im = 0.f;
                ssm_run<false>(p, gi, (size_t)b * TP + seg * SEG, SEG / 16, s_re, s_im, wl, lane);
                float* SE = (float*)(ws + WS_SE) + ((size_t)bg * NSEG + seg) * 128; SE[lane] = s_re; SE[64 + lane] = s_im;
            }
        }
        {
            const int lane = lane_id();
            const bool xmap = (G % 8 == 0);
            const int wxs = xmap ? (G / 8) * 8 : NGW, wx0 = xmap ? (int)(blockIdx.x >> 3) * 8 + wave : gw;
            for (int r0 = wx0; r0 < (xmap ? 1024 : N_MP); r0 += wxs) {
                const int r = xmap ? ((int)(blockIdx.x & 7) << 10) + r0 : r0;
                const int h = r & 3, qb = (r >> 2) & 255, b = r >> 10;
                const size_t qrow = (size_t)b * TP + qb * 16; const bf16_t* MKV = (const bf16_t*)(ws + WS_MKV) + (size_t)b * 256 * 2048 + h * 256;
                attn_item<1, 256, false, true>(PROJ + qrow * NIN5 + 4096 + h * 256, NIN5, MKV, MKV + 1024, (size_t)64 * 2048, 2048, 4,
                                         nullptr, nullptr, 0, 0, false, 0, 0, 0.0625f, nullptr, OM + qrow * 1024 + h * 256, 1024, wl, lane, (const bf16_t*)(ws + WS_MVT) + (size_t)(b * 4 + h) * 65536);
            }
        }
        {
            const int lane = lane_id();
            for (int r = (gw + NGW - 1536) % NGW; r < N_BS; r += NGW) {
                const int h = r & 15, b = r >> 4; const size_t qrow = (size_t)MP + b * 16;
                const bf16_t* CK = (const bf16_t*)(ws + WS_CK) + (size_t)b * 512 * 1024 + h * 64; const bf16_t* CV = (const bf16_t*)(ws + WS_CV) + (size_t)b * 512 * 1024 + h * 64;
                attn_item<1, 64, true, false>(PROJ + qrow * NIN5 + 1024 + h * 64, NIN5, CK, CV, (size_t)64 * 1024, 1024, 8,
                                       PROJ + qrow * NIN5 + 2048 + h * 64, PROJ + qrow * NIN5 + 3072 + h * 64, NIN5, 16, true, 4096, 3584, 0.125f, p.in[I_RELB] + h * 257,
                                       OA + qrow * 1024 + h * 64, 1024, wl, lane);
            }
        }
        {
            const int lane = lane_id();
            for (int r = (gw + NGW - 1800) % NGW; r < N_MSs; r += NGW) {
                const int h = r & 3, b = r >> 2; const size_t qrow = (size_t)MP + b * 16;
                const bf16_t* CMK = (const bf16_t*)(ws + WS_CMK) + (size_t)b * 256 * 1024 + h * 256; const bf16_t* CMV = (const bf16_t*)(ws + WS_CMV) + (size_t)b * 256 * 1024 + h * 256;
                attn_item<1, 256, false, true>(PROJ + qrow * NIN5 + 4096 + h * 256, NIN5, CMK, CMV, (size_t)64 * 1024, 1024, 4,
                                         nullptr, nullptr, 0, 0, false, 0, 0, 0.0625f, nullptr, OM + qrow * 1024 + h * 256, 1024, wl, lane, (const bf16_t*)(ws + WS_CMVT) + (size_t)(b * 4 + h) * 65536);
            }
        }
    }
    SEAM(5);
    if (IN(6)) {
        const int lane = lane_id();
        constexpr int N_SB = 8 * 64 * NSEG, N_SS = 16 * 64;
        const float* SAB = (const float*)(ws + WS_SAB);
        for (int it = gw; it < N_SB + N_SS; it += NGW) {
            if (it < N_SB) {
                const int gi = it & 63, seg = (it >> 6) & (NSEG - 1), b = it >> 10, bg = b * 64 + gi;
                const f32x4 ab = *(const f32x4*)(SAB + (size_t)(gi * 64 + lane) * 4);
                float s_re = 0.f, s_im = 0.f; const float* SE = (const float*)(ws + WS_SE) + (size_t)bg * NSEG * 128;
                for (int i = 0; i < seg; ++i) { const float er = SE[i * 128 + lane], ei = SE[i * 128 + 64 + lane];
                    const float nr = fmaf(ab[2], s_re, fmaf(-ab[3], s_im, er)), ni = fmaf(ab[2], s_im, fmaf(ab[3], s_re, ei)); s_re = nr; s_im = ni; }
                ssm_run<true>(p, gi, (size_t)b * TP + seg * SEG, SEG / 16, s_re, s_im, wl, lane);
                if (seg == NSEG - 1) { p.out[O_SRE_P + (size_t)bg * 64 + lane] = s_re; p.out[O_SIM_P + (size_t)bg * 64 + lane] = s_im; }
            } else {
                const int bg = it - N_SB, gi = bg & 63, b = bg >> 6;
                float s_re = p.in[I_SRE][(size_t)bg * 64 + lane], s_im = p.in[I_SIM][(size_t)bg * 64 + lane];
                ssm_run<true>(p, gi, (size_t)MP + b * 16, 1, s_re, s_im, wl, lane);
                p.out[O_SRE_S + (size_t)bg * 64 + lane] = s_re; p.out[O_SIM_S + (size_t)bg * 64 + lane] = s_im;
            }
        }
    }
    SEAM(6);
    if (IN(7)) {
        { pg8::Gemm g{YS, (const bf16_t*)(ws + WS_WGLU), 1024, 0, 0}; pg8::Sched S; S.init(M, 1024, G, blockIdx.x, 1); pg8::EpiGlu E{YS, p.in[I_SBGLU], OS}; pg8::gemm_phase(lds, g, S, E, wave); }
        { pg8::Gemm g{U, (const bf16_t*)(ws + WS_WIN) + (size_t)NIN5 * D, D, 0, 0}; pg8::Sched S; S.init(M, NGATE, G, (blockIdx.x + G - 4) % G, 1); pg8::EpiGate E{BIG};
        pg8::gemm_phase(lds, g, S, E, wave); }
    }
    SEAM(7);
    if (IN(8)) {
        pg8::Gemm g{OS, (const bf16_t*)(ws + WS_WBR), 1024, (size_t)M * 1024 * 2, (size_t)2048 * 1024 * 2}; pg8::Sched S; S.init(M, D, G, blockIdx.x, 3); pg8::EpiBranch E{BIG, U}; pg8::gemm_phase(lds, g, S, E, wave); }
    SEAM(8);
    if (IN(9)) {
        { pg8::Gemm g{U, (const bf16_t*)(ws + WS_WOUT), D, 0, 0}; pg8::Sched S; S.init(MP, D, G, blockIdx.x, 1); pg8::EpiDown E{YO, RSQ}; pg8::gemm_phase(lds, g, S, E, wave); }
        { pg8::Gemm g{U + (size_t)MP * D, (const bf16_t*)(ws + WS_WOUT), 512, 1024, 1024, D}; pg8::SchedSplit S{8, 4, G, (int)blockIdx.x}; pg8::EpiSplitAcc E{(float*)(ws + WS_ZS)}; pg8::gemm_phase(lds, g, S, E, wave); }
    }
    SEAM(9);
    if (IN(10)) ew_phase<2>(p, p.in[I_MIXPOST], p.in[I_F2PRE], gw, NGW, lane_id(), 4);
    SEAM(10);
    if (IN(11)) {
        pg8::Gemm g{U, (const bf16_t*)(ws + WS_WGU2), D, 0, 0}; pg8::Sched S; S.init(M, 2 * FF, G, blockIdx.x, 1); pg8::EpiSwiglu E{BIG}; pg8::gemm_phase(lds, g, S, E, wave); }
    SEAM(11);
    if (IN(12)) {
        { pg8::Gemm g{BIG, (const bf16_t*)(ws + WS_WD2), FF, 0, 0}; pg8::Sched S; S.init(MP, D, G, blockIdx.x, 1); pg8::EpiDown E{YO, RSQ}; pg8::gemm_phase(lds, g, S, E, wave); }
        { pg8::Gemm g{BIG + (size_t)MP * FF, (const bf16_t*)(ws + WS_WD2), 512, 1024, 1024, FF}; pg8::SchedSplit S{8, 11, G, (int)blockIdx.x}; pg8::EpiSplitAcc E{(float*)(ws + WS_ZS)}; pg8::gemm_phase(lds, g, S, E, wave); }
    }
    SEAM(12);
    if (IN(13)) ew_phase<3>(p, p.in[I_F2POST], nullptr, gw, NGW, lane_id(), 11);
#undef IN
#undef SEAM
}

extern "C" void kernel_launch(void* const* d_in, const int* in_sizes, int n_in, void* d_out, int out_size, void* d_ws, size_t ws_size, hipStream_t stream) {
    static int grid = 0;
    if (grid == 0) {
        if (n_in != 40 || ws_size < WS_END) { fprintf(stderr, "kernel_launch: unexpected n_in %d / ws %zu\n", n_in, ws_size); grid = -1; return; }
        int dev = 0, cus = 0, per_cu = 0;
        hipGetDevice(&dev); hipDeviceGetAttribute(&cus, hipDeviceAttributeMultiprocessorCount, dev);
        if (hipFuncSetAttribute((const void*)mega_fwd, hipFuncAttributeMaxDynamicSharedMemorySize, LDS_BYTES) != hipSuccess) { fprintf(stderr, "kernel_launch: hipFuncSetAttribute failed\n"); grid = -1; return; }
        if (hipOccupancyMaxActiveBlocksPerMultiprocessor(&per_cu, (const void*)mega_fwd, 512, LDS_BYTES) != hipSuccess || per_cu < 1) { fprintf(stderr, "kernel_launch: occupancy query says %d\n", per_cu); per_cu = 1; }
        (void)hipGetLastError();
        grid = cus * per_cu;
    }
    if (grid < 0) return;
    if (hipMemsetAsync(d_ws, 0, 16384, stream) != hipSuccess) { fprintf(stderr, "kernel_launch: memset of barrier words failed\n"); return; }
    Params p{};
    for (int i = 0; i < 40; ++i) p.in[i] = (const float*)d_in[i];
    p.out = (float*)d_out; p.ws = (unsigned char*)d_ws; p.ph_lo = 0; p.ph_hi = 14;
    void* args[] = {&p};
    hipError_t e = hipLaunchCooperativeKernel((const void*)mega_fwd, dim3(grid), dim3(512), args, LDS_BYTES, stream);
    if (e != hipSuccess) fprintf(stderr, "cooperative launch failed: %s (grid %d)\n", hipGetErrorString(e), grid);
}
```
